# Optimizing an MI355X kernel written in HIP

```python
import math
import jax, jax.numpy as jnp
from jax import lax
import numpy as np

D_MODEL = 1024
BATCH = 8
SEQ = 2048
DEPTH = 2

CHUNK = 64
RET_HEADS = 4
RET_DK = 128
RET_DV = 256
RET_QK = RET_HEADS * RET_DK
RET_V = RET_HEADS * RET_DV
ROPE_BASE = 10000.0
HG_HEADS = 8
HG_DK = 128
HG_DV = 128
HG_K = HG_HEADS * HG_DK
HG_V = HG_HEADS * HG_DV
HG_BLOCK = 16
SWA_HQ = 16
SWA_HKV = 4
SWA_HD = 64
SWA_Q = SWA_HQ * SWA_HD
SWA_KV = SWA_HKV * SWA_HD
SWA_WINDOW = 128
SWA_WIN_CHUNKS = SWA_WINDOW // CHUNK
D_FF = 2816
N_EXPERTS = 8
TOP_K = 2
D_EXP = 3584
N_DENSE = (DEPTH + 1) // 2
N_MOE = DEPTH // 2
LN_EPS = 1e-5
RMS_EPS = 1e-6
DN_ALPHA = (2.0 * DEPTH) ** 0.25
DN_BETA = (8.0 * DEPTH) ** -0.25
IN_SPLITS = (RET_QK, RET_QK, RET_V, RET_V,
             HG_K, HG_K, HG_V, HG_V,
             SWA_Q, SWA_KV, SWA_KV,
             D_MODEL, D_MODEL, D_MODEL)
N_IN = sum(IN_SPLITS)

kernel_name = "hybrid_retention_hgrn2_swa_moe_deepnorm"


def layer_norm(x, g, b):
    xf = x.astype(jnp.float32)
    mu = jnp.mean(xf, -1, keepdims=True)
    var = jnp.mean(jnp.square(xf - mu), -1, keepdims=True)
    return ((xf - mu) * lax.rsqrt(var + LN_EPS) * g + b).astype(x.dtype)


def rms_norm(x):
    xf = x.astype(jnp.float32)
    return xf * lax.rsqrt(jnp.mean(xf * xf, -1, keepdims=True) + RMS_EPS)


def rotary(x, pos):
    half = x.shape[-1] // 2
    inv = 1.0 / (ROPE_BASE ** jnp.linspace(0.0, 1.0, half, dtype=jnp.float32))
    ang = pos[:, None] * inv[None, :]
    cos = jnp.cos(ang)[None, :, None, :]
    sin = jnp.sin(ang)[None, :, None, :]
    x1, x2 = x[..., :half], x[..., half:]
    return jnp.concatenate([x1 * cos - x2 * sin, x1 * sin + x2 * cos], axis=-1)


def retention(q, k, v):
    B, S, H, DK = q.shape
    DV = v.shape[-1]
    n = S // CHUNK
    log_gamma = jnp.log(1.0 - 2.0 ** (-5.0 - jnp.arange(H, dtype=jnp.float32)))
    k = k * DK ** -0.5
    qc = q.reshape(B, n, CHUNK, H, DK)
    kc = k.reshape(B, n, CHUNK, H, DK)
    vc = v.reshape(B, n, CHUNK, H, DV)
    idx = jnp.arange(CHUNK, dtype=jnp.float32)
    diff = idx[:, None] - idx[None, :]
    decay = jnp.where(diff[None] >= 0,
                      jnp.exp(jnp.maximum(diff, 0.0)[None] * log_gamma[:, None, None]), 0.0)
    scores = jnp.einsum('bnthd,bnshd->bnhts', qc, kc) * decay
    o_intra = jnp.einsum('bnhts,bnshv->bnthv', scores, vc)
    k_decay = jnp.exp((CHUNK - 1.0 - idx)[:, None] * log_gamma[None, :])
    q_decay = jnp.exp((idx + 1.0)[:, None] * log_gamma[None, :])
    chunk_decay = jnp.exp(CHUNK * log_gamma)[None, :, None, None]

    def step(state, inp):
        q_n, k_n, v_n = inp
        o = jnp.einsum('bthd,th,bhdv->bthv', q_n, q_decay, state)
        state = chunk_decay * state + jnp.einsum('bshd,sh,bshv->bhdv', k_n, k_decay, v_n)
        return state, o

    init = jnp.zeros((B, H, DK, DV), jnp.float32)
    _, o_inter = lax.scan(step, init, (jnp.moveaxis(qc, 1, 0), jnp.moveaxis(kc, 1, 0),
                                       jnp.moveaxis(vc, 1, 0)))
    return (o_intra + jnp.moveaxis(o_inter, 0, 1)).reshape(B, S, H, DV)


def hgrn2_scan(q, log_f, k, v):
    B, S, H, DK = q.shape
    DV = v.shape[-1]
    n = S // HG_BLOCK
    L = HG_BLOCK
    qc = q.reshape(B, n, L, H, DK)
    kc = k.reshape(B, n, L, H, DK)
    vc = v.reshape(B, n, L, H, DV)
    bcum = jnp.cumsum(log_f.reshape(B, n, L, H, DK), axis=2)
    q_t = qc * jnp.exp(bcum)
    k_t = kc * jnp.exp(-bcum)
    causal = jnp.tril(jnp.ones((L, L), dtype=bool))
    a = jnp.where(causal, jnp.einsum('bnthd,bnshd->bnhts', q_t, k_t), 0.0)
    o_intra = jnp.einsum('bnhts,bnshv->bnthv', a, vc)
    b_last = bcum[:, :, -1]
    k_state = kc * jnp.exp(b_last[:, :, None] - bcum)
    blk_decay = jnp.exp(b_last)

    def step(state, inp):
        q_n, ks_n, v_n, d_n = inp
        o = jnp.einsum('bthd,bhdv->bthv', q_n, state)
        state = d_n[..., None] * state + jnp.einsum('bshd,bshv->bhdv', ks_n, v_n)
        return state, o

    init = jnp.zeros((B, H, DK, DV), jnp.float32)
    _, o_inter = lax.scan(step, init, (jnp.moveaxis(q_t, 1, 0), jnp.moveaxis(k_state, 1, 0),
                                       jnp.moveaxis(vc, 1, 0), jnp.moveaxis(blk_decay, 1, 0)))
    return (o_intra + jnp.moveaxis(o_inter, 0, 1)).reshape(B, S, H, DV)


def swa_with_sinks(q, k, v, sinks):
    B, S, HQ, HD = q.shape
    HKV = k.shape[2]
    G = HQ // HKV
    W = SWA_WIN_CHUNKS
    n = S // CHUNK
    qc = q.astype(jnp.float32).reshape(B, n, CHUNK, HKV, G, HD)
    kc = k.astype(jnp.float32).reshape(B, n, CHUNK, HKV, HD)
    vc = v.astype(jnp.float32).reshape(B, n, CHUNK, HKV, HD)
    padw = ((0, 0), (W, 0), (0, 0), (0, 0), (0, 0))
    kp = jnp.pad(kc, padw)
    vp = jnp.pad(vc, padw)
    kb = jnp.concatenate([kp[:, j:j + n] for j in range(W + 1)], axis=2)
    vb = jnp.concatenate([vp[:, j:j + n] for j in range(W + 1)], axis=2)
    chunk_ids = jnp.arange(n)[:, None] - W + jnp.arange(W + 1)[None, :]
    valid = jnp.repeat(chunk_ids >= 0, CHUNK, axis=1)
    s = jnp.einsum('bntkgd,bnskd->bnkgts', qc, kb) * HD ** -0.5
    s = jnp.where(valid[None, :, None, None, None, :], s, -jnp.inf)
    sink = sinks.astype(jnp.float32).reshape(HKV, G)[None, None, :, :, None, None]
    m = jnp.maximum(jnp.max(s, -1, keepdims=True), sink)
    p = jnp.exp(s - m)
    p = p / (jnp.sum(p, -1, keepdims=True) + jnp.exp(sink - m))
    o = jnp.einsum('bnkgts,bnskd->bntkgd', p, vb)
    return o.reshape(B, S, HQ * HD)


def swiglu(h, w_gate, w_up, w_down):
    return (jax.nn.silu(h @ w_gate) * (h @ w_up)) @ w_down


def moe_swiglu(h2, w_router, w_gate, w_up, w_down):
    logits = (h2 @ w_router).astype(jnp.float32)
    top_logits, top_idx = lax.top_k(logits, TOP_K)
    top_w = jax.nn.softmax(top_logits, axis=-1)
    flat_e = top_idx.reshape(-1)
    order = jnp.argsort(flat_e)
    tok = order // TOP_K
    xs = h2[tok]
    sizes = jnp.bincount(flat_e, length=N_EXPERTS).astype(jnp.int32)
    hid = jax.nn.silu(lax.ragged_dot(xs, w_gate, sizes)) * lax.ragged_dot(xs, w_up, sizes)
    y = lax.ragged_dot(hid, w_down, sizes)
    y = y * top_w.reshape(-1)[order][:, None].astype(y.dtype)
    return jnp.zeros_like(h2).at[tok].add(y.astype(h2.dtype))


def setup_inputs(seed: int = 0) -> dict:
    key = jax.random.key(seed)
    ks = jax.random.split(key, 24)
    f32 = jnp.float32
    D = D_MODEL

    def nrm(k, shape, scale):
        return jax.random.normal(k, shape, f32) * scale

    return {
        'x': nrm(ks[0], (BATCH, SEQ, D), 1.0),
        'ln_in_g': 1.0 + nrm(ks[1], (D,), 0.02),
        'ln_in_b': nrm(ks[2], (D,), 0.02),
        'w_in': nrm(ks[3], (DEPTH, D, N_IN), D ** -0.5),
        'ret_w_out': nrm(ks[4], (DEPTH, RET_V, D), DN_BETA * RET_V ** -0.5),
        'hgrn_lower_bounds': 1.0 + nrm(ks[5], (DEPTH, HG_K), 0.5),
        'hgrn_norm_g': 1.0 + nrm(ks[6], (DEPTH, HG_DV), 0.02),
        'hgrn_w_out': nrm(ks[7], (DEPTH, HG_V, D), DN_BETA * HG_V ** -0.5),
        'swa_sinks': nrm(ks[8], (DEPTH, SWA_HQ), 0.5),
        'swa_w_out': nrm(ks[9], (DEPTH, SWA_Q, D), DN_BETA * SWA_Q ** -0.5),
        'w_o': nrm(ks[10], (DEPTH, D, D), DN_BETA * D ** -0.5),
        'ln_mix_g': 1.0 + nrm(ks[11], (DEPTH, D), 0.02),
        'ln_mix_b': nrm(ks[12], (DEPTH, D), 0.02),
        'ffn_w_gate': nrm(ks[13], (N_DENSE, D, D_FF), D ** -0.5),
        'ffn_w_up': nrm(ks[14], (N_DENSE, D, D_FF), D ** -0.5),
        'ffn_w_down': nrm(ks[15], (N_DENSE, D_FF, D), DN_BETA * D_FF ** -0.5),
        'moe_router': nrm(ks[16], (N_MOE, D, N_EXPERTS), D ** -0.5),
        'moe_w_gate': nrm(ks[17], (N_MOE, N_EXPERTS, D, D_EXP), D ** -0.5),
        'moe_w_up': nrm(ks[18], (N_MOE, N_EXPERTS, D, D_EXP), D ** -0.5),
        'moe_w_down': nrm(ks[19], (N_MOE, N_EXPERTS, D_EXP, D), DN_BETA * D_EXP ** -0.5),
        'ln_ffn_g': 1.0 + nrm(ks[20], (DEPTH, D), 0.02),
        'ln_ffn_b': nrm(ks[21], (DEPTH, D), 0.02),
    }


def reference(x, ln_in_g, ln_in_b, w_in, ret_w_out, hgrn_lower_bounds, hgrn_norm_g, hgrn_w_out,
              swa_sinks, swa_w_out, w_o, ln_mix_g, ln_mix_b, ffn_w_gate, ffn_w_up, ffn_w_down,
              moe_router, moe_w_gate, moe_w_up, moe_w_down, ln_ffn_g, ln_ffn_b):
    B, S, D = x.shape
    f32 = jnp.float32
    pos = jnp.arange(S, dtype=f32)
    split_points = np.cumsum(np.array(IN_SPLITS))[:-1].tolist()
    lb_all = jnp.cumsum(jax.nn.softmax(hgrn_lower_bounds.astype(f32), axis=0), axis=0)
    lb_all = lb_all - lb_all[0]

    h = layer_norm(x, ln_in_g, ln_in_b)
    for layer in range(DEPTH):
        proj = jnp.einsum('bsd,dc->bsc', h, w_in[layer])
        (rq, rk, rv, rg, hq, hf, hi, hg, sq, sk, sv, ga, gb, gc) = jnp.split(proj, split_points, axis=-1)

        r_q = rotary(rq.astype(f32).reshape(B, S, RET_HEADS, RET_DK), pos)
        r_k = rotary(rk.astype(f32).reshape(B, S, RET_HEADS, RET_DK), pos)
        r_v = rv.astype(f32).reshape(B, S, RET_HEADS, RET_DV)
        r_o = rms_norm(retention(r_q, r_k, r_v)).reshape(B, S, RET_V)
        y_a = (jax.nn.silu(rg.astype(f32)) * r_o) @ ret_w_out[layer]

        lb = lb_all[layer].reshape(HG_HEADS, HG_DK)
        z = hf.astype(f32).reshape(B, S, HG_HEADS, HG_DK)
        log_f = jnp.logaddexp(jnp.log(lb), jnp.log1p(-lb) + jax.nn.log_sigmoid(z))
        h_k = -jnp.expm1(log_f)
        h_q = hq.astype(f32).reshape(B, S, HG_HEADS, HG_DK)
        h_v = hi.astype(f32).reshape(B, S, HG_HEADS, HG_DV)
        h_o = rms_norm(hgrn2_scan(h_q, log_f, h_k, h_v)) * hgrn_norm_g[layer]
        y_b = (jax.nn.silu(hg.astype(f32)) * h_o.reshape(B, S, HG_V)) @ hgrn_w_out[layer]

        s_o = swa_with_sinks(sq.reshape(B, S, SWA_HQ, SWA_HD), sk.reshape(B, S, SWA_HKV, SWA_HD),
                             sv.reshape(B, S, SWA_HKV, SWA_HD), swa_sinks[layer])
        y_c = s_o @ swa_w_out[layer]

        merged = (jax.nn.sigmoid(ga.astype(f32)) * y_a + jax.nn.sigmoid(gb.astype(f32)) * y_b
                  + jax.nn.sigmoid(gc.astype(f32)) * y_c)
        mix = merged @ w_o[layer]
        h = layer_norm((DN_ALPHA * h + mix).astype(h.dtype), ln_mix_g[layer], ln_mix_b[layer])

        j = layer // 2
        if layer % 2 == 0:
            ff = swiglu(h, ffn_w_gate[j], ffn_w_up[j], ffn_w_down[j])
        else:
            ff = moe_swiglu(h.reshape(B * S, D), moe_router[j], moe_w_gate[j], moe_w_up[j],
                            moe_w_down[j]).reshape(B, S, D)
        h = layer_norm((DN_ALPHA * h + ff).astype(h.dtype), ln_ffn_g[layer], ln_ffn_b[layer])
    return h
```

```cpp
#include <hip/hip_runtime.h>
#include <cstdio>
#include <cstdint>
#ifndef MK_SINGLE
#define MK_SINGLE 1
#endif
namespace pg8 {
#define PG8_LAS __attribute__((address_space(3)))
typedef unsigned short bf16_t;
typedef short bf16x8 __attribute__((ext_vector_type(8)));
typedef float f32x4 __attribute__((ext_vector_type(4)));
typedef unsigned u32x4 __attribute__((ext_vector_type(4)));
constexpr int BM = 256, BK = 64, HALF = 128, HTB = HALF * BK * 2  , STAGE_BYTES = 8 * HTB, NXCD = 8, WGM = 8;

__host__ __device__ __forceinline__ int lds_byte(int r, int c) { const int st = (r >> 4) * 2 + (c >> 5), rr = r & 15, cc = c & 31, ob = rr * 64 + cc * 2; return st * 1024 + (ob ^ (((ob >> 9) & 1) << 5)); }
__host__ __device__ __forceinline__ void stage_rc(int b, int& R, int& C) { const int st = b / 1024, sb = b % 1024, swz = sb ^ (((sb >> 9) & 1) << 5); R = (st >> 1) * 16 + swz / 64; C = (st & 1) * 32 + (swz % 64) / 2; }
__host__ __device__ __forceinline__ int perm32(int rho) { const int n = rho >> 4, i = rho & 15; return 8 * (i >> 2) + 4 * n + (i & 3); }

struct Unit { int pm, pn; };
struct Gemm { const bf16_t* A; const bf16_t* Bt; int M, N, K; };

struct StaticOrder {
    int nM, nN, nwg, G, c;
    __host__ __device__ void init(int M, int N, int G_, int c_) { nM = M / BM; nN = N / BM; nwg = nM * nN; G = G_; c = c_; }
    __host__ __device__ bool next(int i, Unit& u) const {
        const long L = (long)i * G + c; if (L >= nwg) return false;
        int wgid = (int)L; { const int q = nwg / NXCD, r = nwg % NXCD, xcd = wgid % NXCD, off = wgid / NXCD; wgid = (xcd < r ? xcd * (q + 1) : r * (q + 1) + (xcd - r) * q) + off; }
        const int nig = WGM * nN, gid = wgid / nig, fm = gid * WGM, gsz = (nM - fm) < WGM ? (nM - fm) : WGM;
        u.pm = fm + ((wgid % nig) % gsz); u.pn = (wgid % nig) / gsz; return true;
    }
    __device__ __forceinline__ void a_ready(const Unit&) const {}
    __device__ __forceinline__ void done(const Unit&) const {}
};
__device__ __forceinline__ unsigned cvt_pk_bf16(float lo, float hi) { unsigned r; asm volatile("v_cvt_pk_bf16_f32 %0, %1, %2" : "=v"(r) : "v"(lo), "v"(hi)); return r; }
typedef float f32x2 __attribute__((ext_vector_type(2)));
template <class Epi, class Sched, bool ALIGN_EPI = false, bool SP2 = false>
__device__ __forceinline__ void gemm_phase(PG8_LAS unsigned char* lds, const Gemm g, const Sched& S, const Epi& E) {
    int tid_ = threadIdx.x; asm volatile("" : "+v"(tid_));
    const int tid = tid_, wid = __builtin_amdgcn_readfirstlane(tid >> 6), lane = tid & 63, wr = wid >> 2, wc = wid & 3, fr = lane & 15, fq = lane >> 4;
    const int K = g.K, nt = K / BK;
    unsigned voffA[2], voffB[2];
#pragma unroll
    for (int i = 0; i < 2; ++i) { int R, C; stage_rc(tid * 16 + i * 8192, R, C); const int Rb = Epi::PERM ? ((R & ~31) + perm32(R & 31)) : R;
        voffA[i] = (unsigned)(R * K + C) * 2u; voffB[i] = (unsigned)(Rb * K + C) * 2u; }
    const size_t kstep = (size_t)(BK * 2);
    const size_t hstep = (size_t)HALF * K * 2;
    const size_t tstep = 2 * hstep;
    const unsigned ldsw = (unsigned)wid * 1024u;
    const int aoff = lds_byte(wr * 64 + fr, fq * 8), boff = lds_byte(wc * 32 + fr, fq * 8);
#define PG8_SA(b, h) (((b) * 2 + (h)) * HTB)
#define PG8_SB(b, h) ((4 + (b) * 2 + (h)) * HTB)
#define PG8_STAGE(bufoff, gbase, voff) do { _Pragma("unroll") for (int _i = 0; _i < 2; ++_i) \
        __builtin_amdgcn_global_load_lds((const unsigned*)((const char*)(gbase) + (voff)[_i]), (PG8_LAS unsigned*)(lds + (bufoff) + ldsw + _i * 8192), 16, 0, 0); } while (0)
#define PG8_LDA(dst, b, h) do { _Pragma("unroll") for (int m = 0; m < 4; ++m) _Pragma("unroll") for (int k = 0; k < 2; ++k) dst[m][k] = *(const PG8_LAS bf16x8*)(lds + PG8_SA(b, h) + aoff + m * 2048 + k * 1024); } while (0)
#define PG8_LDB(dst, b, h) do { _Pragma("unroll") for (int n = 0; n < 2; ++n) _Pragma("unroll") for (int k = 0; k < 2; ++k) dst[n][k] = *(const PG8_LAS bf16x8*)(lds + PG8_SB(b, h) + boff + n * 2048 + k * 1024); } while (0)
#define PG8_MMA(ai, bj, At, Bt) do { __builtin_amdgcn_s_setprio(1); _Pragma("unroll") for (int m = 0; m < 4; ++m) _Pragma("unroll") for (int n = 0; n < 2; ++n) _Pragma("unroll") for (int k = 0; k < 2; ++k) \
        acc[ai][bj][m][n] = __builtin_amdgcn_mfma_f32_16x16x32_bf16(Bt[n][k], At[m][k], acc[ai][bj][m][n], 0, 0, 0); __builtin_amdgcn_s_setprio(0); } while (0)
#define PG8_WAIT_V(n) asm volatile("s_waitcnt vmcnt(" #n ")" ::: "memory")
#define PG8_WAIT_L(n) asm volatile("s_waitcnt lgkmcnt(" #n ")" ::: "memory")
#define PG8_BAR __builtin_amdgcn_s_barrier()
#define PG8_SCHED __builtin_amdgcn_sched_barrier(0)
    Unit cur, nxt; int ui = 0;
    if (!S.next(0, cur)) return;
    f32x4 acc[2][2][4][2];
#pragma unroll
    for (int a = 0; a < 2; ++a)
#pragma unroll
        for (int b = 0; b < 2; ++b)
#pragma unroll
            for (int m = 0; m < 4; ++m)
#pragma unroll
                for (int n = 0; n < 2; ++n) acc[a][b][m][n] = (f32x4){0.f, 0.f, 0.f, 0.f};
    bf16x8 At[4][2], B0[2][2], B1[2][2];
    const char* cA = (const char*)g.A + (size_t)cur.pm * tstep; const char* cB = (const char*)g.Bt + (size_t)cur.pn * tstep;
    S.a_ready(cur);
    if constexpr (SP2) {
        PG8_STAGE(PG8_SB(0, 0), cB, voffB); PG8_STAGE(PG8_SB(0, 1), cB + hstep, voffB); PG8_STAGE(PG8_SA(0, 0), cA, voffA); PG8_STAGE(PG8_SA(0, 1), cA + hstep, voffA);
        if (wr == 1) PG8_BAR;
        PG8_WAIT_V(2); PG8_BAR;
        PG8_STAGE(PG8_SB(1, 0), cB + kstep, voffB); PG8_STAGE(PG8_SA(1, 0), cA + kstep, voffA); PG8_STAGE(PG8_SB(1, 1), cB + hstep + kstep, voffB);
        PG8_WAIT_V(6); PG8_BAR;
    } else {
        PG8_STAGE(PG8_SB(0, 0), cB, voffB); PG8_STAGE(PG8_SA(0, 0), cA, voffA); PG8_STAGE(PG8_SB(0, 1), cB + hstep, voffB); PG8_STAGE(PG8_SA(0, 1), cA + hstep, voffA);
        if (wr == 1) PG8_BAR;
        PG8_WAIT_V(4); PG8_BAR;
        PG8_STAGE(PG8_SB(1, 0), cB + kstep, voffB); PG8_STAGE(PG8_SA(1, 0), cA + kstep, voffA); PG8_STAGE(PG8_SB(1, 1), cB + hstep + kstep, voffB);
        PG8_WAIT_V(6); PG8_BAR;
    }
    for (;;) {
        const bool has_next = S.next(ui + 1, nxt);
        const char* nA = has_next ? (const char*)g.A + (size_t)nxt.pm * tstep : cA; const char* nB = has_next ? (const char*)g.Bt + (size_t)nxt.pn * tstep : cB;
        for (int t = 0; t < nt; t += 2) {
            const bool last = (t == nt - 2);
            const char* a1 = cA + (size_t)(t + 1) * kstep;
            const char* a2 = last ? nA : cA + (size_t)(t + 2) * kstep; const char* b2 = last ? nB : cB + (size_t)(t + 2) * kstep;
            const char* a3 = a2 + kstep; const char* b3 = b2 + kstep;
            if (last && has_next) S.a_ready(nxt);
            if constexpr (SP2) {
            PG8_LDB(B0, 0, 0); PG8_LDB(B1, 0, 1); PG8_SCHED; PG8_LDA(At, 0, 0); PG8_STAGE(PG8_SA(1, 1), a1 + hstep, voffA);
            PG8_WAIT_V(8); PG8_WAIT_L(0); PG8_BAR; PG8_MMA(0, 0, At, B0); PG8_MMA(0, 1, At, B1); PG8_BAR; PG8_SCHED;
            PG8_LDA(At, 0, 1); PG8_STAGE(PG8_SB(0, 0), b2, voffB); PG8_STAGE(PG8_SB(0, 1), b2 + hstep, voffB); PG8_STAGE(PG8_SA(0, 0), a2, voffA);
            PG8_WAIT_V(8); PG8_WAIT_L(0); PG8_BAR; PG8_MMA(1, 0, At, B0); PG8_MMA(1, 1, At, B1); PG8_BAR; PG8_SCHED;
            PG8_LDB(B0, 1, 0); PG8_LDB(B1, 1, 1); PG8_SCHED; PG8_LDA(At, 1, 0); PG8_STAGE(PG8_SA(0, 1), a2 + hstep, voffA);
            PG8_WAIT_V(8); PG8_WAIT_L(0); PG8_BAR; PG8_MMA(0, 0, At, B0); PG8_MMA(0, 1, At, B1); PG8_BAR; PG8_SCHED;
            PG8_LDA(At, 1, 1); PG8_STAGE(PG8_SB(1, 0), b3, voffB); PG8_STAGE(PG8_SB(1, 1), b3 + hstep, voffB); PG8_STAGE(PG8_SA(1, 0), a3, voffA);
            PG8_WAIT_V(8); PG8_WAIT_L(0); PG8_BAR; PG8_MMA(1, 0, At, B0); PG8_MMA(1, 1, At, B1); PG8_BAR; PG8_SCHED;
            } else {
            PG8_LDB(B0, 0, 0); PG8_SCHED; PG8_LDA(At, 0, 0); PG8_STAGE(PG8_SA(1, 1), a1 + hstep, voffA);
            PG8_WAIT_L(8); PG8_BAR; PG8_WAIT_L(0); PG8_MMA(0, 0, At, B0); PG8_BAR; PG8_SCHED;
            PG8_LDB(B1, 0, 1); PG8_STAGE(PG8_SB(0, 0), b2, voffB);
            PG8_BAR; PG8_WAIT_L(0); PG8_MMA(0, 1, At, B1); PG8_BAR;
            PG8_LDA(At, 0, 1); PG8_STAGE(PG8_SA(0, 0), a2, voffA);
            PG8_BAR; PG8_WAIT_L(0); PG8_MMA(1, 0, At, B0); PG8_BAR; PG8_SCHED;
            PG8_STAGE(PG8_SB(0, 1), b2 + hstep, voffB);
            PG8_WAIT_V(6); PG8_BAR; PG8_MMA(1, 1, At, B1); PG8_BAR;
            PG8_LDB(B0, 1, 0); PG8_SCHED; PG8_LDA(At, 1, 0); PG8_STAGE(PG8_SA(0, 1), a2 + hstep, voffA);
            PG8_WAIT_L(8); PG8_BAR; PG8_WAIT_L(0); PG8_MMA(0, 0, At, B0); PG8_BAR; PG8_SCHED;
            PG8_LDB(B1, 1, 1); PG8_STAGE(PG8_SB(1, 0), b3, voffB);
            PG8_BAR; PG8_WAIT_L(0); PG8_MMA(0, 1, At, B1); PG8_BAR;
            PG8_LDA(At, 1, 1); PG8_STAGE(PG8_SA(1, 0), a3, voffA);
            PG8_BAR; PG8_WAIT_L(0); PG8_MMA(1, 0, At, B0); PG8_BAR; PG8_SCHED;
            PG8_STAGE(PG8_SB(1, 1), b3 + hstep, voffB);
            PG8_WAIT_V(6); PG8_BAR; PG8_MMA(1, 1, At, B1); PG8_BAR;
            }
        }
        if constexpr (ALIGN_EPI) { if (wr == 0) PG8_BAR; }
        if constexpr (!Epi::AFTER_DRAIN) { E(acc, cur, wr, wc, fr, fq); S.done(cur); }
        if (!has_next) break;
#pragma unroll
        for (int a = 0; a < 2; ++a)
#pragma unroll
            for (int b = 0; b < 2; ++b)
#pragma unroll
                for (int m = 0; m < 4; ++m)
#pragma unroll
                    for (int n = 0; n < 2; ++n) acc[a][b][m][n] = (f32x4){0.f, 0.f, 0.f, 0.f};
        cur = nxt; cA = nA; cB = nB; ++ui;
        if constexpr (ALIGN_EPI) { if (wr == 1) PG8_BAR; }
    }
    PG8_WAIT_V(0);
    if constexpr (!ALIGN_EPI) { if (wr == 0) PG8_BAR; }
    PG8_BAR;
    if constexpr (Epi::AFTER_DRAIN) { E.fused(acc, cur, wr, wc, fr, fq, lds, wid, lane); S.done(cur); }
#undef PG8_SA
#undef PG8_SB
#undef PG8_STAGE
#undef PG8_LDA
#undef PG8_LDB
#undef PG8_MMA
#undef PG8_WAIT_V
#undef PG8_WAIT_L
#undef PG8_BAR
#undef PG8_SCHED
}
}
#ifndef PG8_SP2
#define PG8_SP2 true
#endif
#ifndef PG8_ALIGN
#define PG8_ALIGN true
#endif
#define GAS __attribute__((address_space(1)))
#define LAS __attribute__((address_space(3)))
typedef unsigned short bf16;
typedef unsigned v4u __attribute__((ext_vector_type(4)));
typedef unsigned v2u __attribute__((ext_vector_type(2)));
typedef float f32x4 __attribute__((ext_vector_type(4)));
typedef float f32x2 __attribute__((ext_vector_type(2)));
typedef GAS unsigned gu32;
#define RLX_AGENT __ATOMIC_RELAXED, __HIP_MEMORY_SCOPE_AGENT
#define LDS_WAIT() asm volatile("s_waitcnt lgkmcnt(0)" ::: "memory")
#define VM_WAIT() asm volatile("s_waitcnt vmcnt(0)" ::: "memory")
__device__ __forceinline__ unsigned f2bf(float f) { unsigned u = __builtin_bit_cast(unsigned, f); return (u + 0x7fffu + ((u >> 16) & 1u)) >> 16; }
__device__ __forceinline__ unsigned pk2(float lo, float hi) { return f2bf(lo) | (f2bf(hi) << 16); }
__device__ __forceinline__ float bf2f(unsigned short b) { return __builtin_bit_cast(float, ((unsigned)b) << 16); }
__device__ __forceinline__ float bflo(unsigned w) { return __builtin_bit_cast(float, w << 16); }
__device__ __forceinline__ float bfhi(unsigned w) { return __builtin_bit_cast(float, w & 0xffff0000u); }
__device__ __forceinline__ float fsigmoid(float x) { return __builtin_amdgcn_rcpf(1.f + __expf(-x)); }
__device__ __forceinline__ float fsilu(float x) { return x * fsigmoid(x); }
__device__ __forceinline__ float wave_sum(float v) {
#pragma unroll
    for (int o = 1; o < 64; o <<= 1) v += __shfl_xor(v, o);
    return v;
}
#define XB_TMO      128
#define XB_XCNT(j)  (256  + 64 * (j))
#define XB_XSUB(j)  (1280 + 64 * (j))
#define XB_XGEN(j)  (2304 + 64 * (j))
#define XB_TOP      3328
#define XB_TOPGEN   3392
#define XCD_BAR_WORDS 3456
#define XB_SPIN_CAP (1u << 18)

__device__ __forceinline__ unsigned xb_ld(unsigned* p)              { return __hip_atomic_load(p, __ATOMIC_RELAXED, __HIP_MEMORY_SCOPE_AGENT); }
__device__ __forceinline__ unsigned xb_add(unsigned* p, unsigned v) { return __hip_atomic_fetch_add(p, v, __ATOMIC_RELAXED, __HIP_MEMORY_SCOPE_AGENT); }
__device__ __forceinline__ unsigned xb_xcc_id() { return (unsigned)__builtin_amdgcn_s_getreg((3 << 11) | 20) & 0xFu; }
#define XB_SPIN(cond, bar) do { unsigned _sp = 0; while (cond) { __builtin_amdgcn_s_sleep(1); \
    if ((++_sp & 255u) == 0u) { if (xb_ld(&(bar)[XB_TMO])) break; if (_sp > XB_SPIN_CAP) { atomicAdd(&(bar)[XB_TMO], 1u); break; } } } } while (0)

struct XcdBarrier {
    unsigned* bar; unsigned x;
    volatile LAS unsigned* st;
};

__device__ __forceinline__ XcdBarrier xcd_barrier_post(unsigned* bar, volatile LAS unsigned* st) {
    XcdBarrier b; b.bar = bar; b.x = xb_xcc_id(); b.st = st;
    if (threadIdx.x == 0) (void)xb_add(&bar[XB_XCNT(b.x)], 1u);
    return b;
}
__device__ __forceinline__ void xcd_barrier_complete(unsigned* bar, unsigned x, unsigned& nloc, unsigned& nx) {
    const unsigned G = gridDim.x * gridDim.y * gridDim.z;
    unsigned sum, cnt, mine, sp = 0u;
    for (;;) {
        sum = 0u; cnt = 0u; mine = 0u;
#pragma unroll
        for (unsigned j = 0; j < 16; ++j) { const unsigned c = xb_ld(&bar[XB_XCNT(j)]); sum += c; cnt += (c > 0u) ? 1u : 0u; mine = (j == x) ? c : mine; }
        if (sum == G) break;
        __builtin_amdgcn_s_sleep(1);
        if ((++sp & 255u) == 0u) { if (xb_ld(&bar[XB_TMO])) break; if (sp > XB_SPIN_CAP) { atomicAdd(&bar[XB_TMO], 1u); break; } }
    }
    nloc = mine > 0u ? mine : 1u; nx = cnt > 0u ? cnt : 1u;
}

__device__ __forceinline__ void xcd_barrier(const XcdBarrier& b) {
    asm volatile("s_waitcnt vmcnt(0)" ::: "memory");
    __syncthreads();
    if (threadIdx.x == 0) {
        unsigned* bar = b.bar;
        __builtin_amdgcn_s_waitcnt(0);
        unsigned nloc = b.st[0], nx = b.st[1];
        if (nloc == 0u) { xcd_barrier_complete(bar, b.x, nloc, nx); b.st[0] = nloc; b.st[1] = nx; }
        const unsigned old = xb_add(&bar[XB_XSUB(b.x)], 1u);
        const unsigned gen = old / nloc;
        if (old + 1u == (gen + 1u) * nloc) {
            __builtin_amdgcn_fence(__ATOMIC_RELEASE, "agent");
            asm volatile("s_waitcnt vmcnt(0)" ::: "memory");
            const unsigned og = xb_add(&bar[XB_TOP], 1u);
            const unsigned tg = og / nx;
            if (og + 1u == (tg + 1u) * nx) xb_add(&bar[XB_TOPGEN], 1u);
            else XB_SPIN(xb_ld(&bar[XB_TOPGEN]) == tg, bar);
            __builtin_amdgcn_fence(__ATOMIC_ACQUIRE, "agent");
            xb_add(&bar[XB_XGEN(b.x)], 1u);
            asm volatile("s_waitcnt vmcnt(0)" ::: "memory");
        } else {
            XB_SPIN(xb_ld(&bar[XB_XGEN(b.x)]) == gen, bar);
            __builtin_amdgcn_fence(__ATOMIC_ACQUIRE, "agent");
            asm volatile("s_waitcnt vmcnt(0)" ::: "memory");
        }
    }
    __syncthreads();
}
constexpr int NWAVES = 8;
constexpr int D = 1024, SEQ = 2048, M = 16384, NIN = 11776, DFF = 2816, NEXP = 8, DEXP = 3584;
constexpr int MOE_ROWS = 136 * 256;
constexpr float DN_ALPHA = 1.41421356237309515f;
constexpr float LN_EPS = 1e-5f, RMS_EPS = 1e-6f;
constexpr size_t MiB = 1u << 20;
constexpr size_t WS_CTL = 0, CTL_ZERO_BYTES = 1 * MiB;
constexpr size_t WS_ROPE = 1 * MiB;
constexpr size_t WS_LB = 2 * MiB;
constexpr size_t WS_TOKI = WS_LB + 65536;
constexpr size_t WS_TOKW = WS_TOKI + (size_t)M * 16;
constexpr size_t WS_RSLOT = WS_TOKW + (size_t)M * 8;
constexpr size_t WS_RW = WS_RSLOT + (size_t)MOE_ROWS * 4;
static_assert(WS_RW + (size_t)MOE_ROWS * 4 <= 4 * MiB, "misc tables");
constexpr size_t WS_WIN = 4 * MiB;
constexpr size_t WS_WOUT = 50 * MiB;
constexpr size_t WS_WGU = 66 * MiB;
constexpr size_t WS_WDN = 77 * MiB;
constexpr size_t WS_HBF = 84 * MiB;
constexpr size_t WS_RQ = 116 * MiB, WS_RK = 132 * MiB, WS_RV = 148 * MiB;
constexpr size_t WS_MACC = 116 * MiB;
constexpr size_t WS_OABC = 180 * MiB;
constexpr size_t WS_GATES = 276 * MiB;
constexpr size_t WS_HQ = 372 * MiB, WS_HF = 404 * MiB, WS_HI = 436 * MiB;
constexpr size_t WS_SK = 468 * MiB, WS_SV = 476 * MiB;
constexpr size_t WS_MERGED = 484 * MiB;
constexpr size_t WS_HID = 180 * MiB;
constexpr size_t WS_WGUE = 116 * MiB;
constexpr size_t WS_WDNE = 228 * MiB;
constexpr size_t WS_HIDE = 284 * MiB;
constexpr size_t WS_XS = 4 * MiB;
constexpr size_t WS_YS = 116 * MiB;
constexpr size_t WS_END = WS_HIDE + (size_t)MOE_ROWS * DEXP * 2;
static_assert(WS_END <= 557 * MiB, "workspace");
static_assert(WS_XS + (size_t)MOE_ROWS * D * 2 <= WS_HBF, "XS");
constexpr int CW_TMO = 0, CW_BAR = 4096, CW_ECNT = 8192;

constexpr int RING_OFF = 0, RING_BYTES = 131072;
constexpr int LDSCTL_OFF = RING_BYTES, MISC_OFF = LDSCTL_OFF + 320;
constexpr int LDS_BYTES = 147456;

using pg8::Unit;
__device__ __forceinline__ v4u pack8(const f32x4& a, const f32x4& b) {
    v4u w; w.x = pg8::cvt_pk_bf16(a[0], a[1]); w.y = pg8::cvt_pk_bf16(a[2], a[3]); w.z = pg8::cvt_pk_bf16(b[0], b[1]); w.w = pg8::cvt_pk_bf16(b[2], b[3]); return w;
}
struct EpiProj {
    static constexpr bool PERM = true, AFTER_DRAIN = false;
    unsigned char* ws; const f32x4* rope;
    __device__ __forceinline__ void operator()(const f32x4 (&acc)[2][2][4][2], const Unit& u, int wr, int wc, int fr, int fq) const {
        const int pn = u.pn; const int row0 = u.pm * 256 + wr * 64 + fr;
        if (pn < 4) {
            bf16* dst = (bf16*)(ws + (pn < 2 ? WS_RQ : WS_RK)); const float sc = pn < 2 ? 1.f : 0.08838834764831845f;
            const int dd0 = (wc & 1) * 32 + 8 * fq, colb = (2 * (pn & 1) + (wc >> 1)) * 128 + dd0;
#pragma unroll
            for (int ai = 0; ai < 2; ++ai)
#pragma unroll
                for (int m = 0; m < 4; ++m) {
                    const int row = row0 + ai * 128 + m * 16, t = row & (SEQ - 1);
                    const f32x4* rp = rope + ((size_t)t * 64 + dd0) / 2;
                    f32x4 o1[2], o2[2];
#pragma unroll
                    for (int n = 0; n < 2; ++n) {
                        const f32x4 ra = rp[2 * n], rb = rp[2 * n + 1];
                        const f32x4 c = (f32x4){ra[0], ra[2], rb[0], rb[2]}, s = (f32x4){ra[1], ra[3], rb[1], rb[3]};
                        const f32x4 x1 = acc[ai][0][m][n], x2 = acc[ai][1][m][n];
                        o1[n] = (x1 * c - x2 * s) * sc; o2[n] = (x1 * s + x2 * c) * sc;
                    }
                    bf16* rowp = dst + (size_t)row * 512 + colb;
                    *(v4u*)rowp = pack8(o1[0], o1[1]); *(v4u*)(rowp + 64) = pack8(o2[0], o2[1]);
                }
            return;
        }
        size_t off; int ldc = 1024, c0, mode = 0;
        if (pn < 8) { off = WS_RV; c0 = pn - 4; }
        else if (pn < 12) { off = WS_OABC; c0 = pn - 8; mode = 1; }
        else if (pn < 16) { off = WS_HQ; c0 = pn - 12; }
        else if (pn < 20) { off = WS_HF; c0 = pn - 16; }
        else if (pn < 24) { off = WS_HI; c0 = pn - 20; }
        else if (pn < 28) { off = WS_OABC + (size_t)M * D * 2; c0 = pn - 24; mode = 1; }
        else if (pn < 32) { off = WS_OABC + (size_t)M * D * 4; c0 = pn - 28; mode = 3; }
        else if (pn < 33) { off = WS_SK; c0 = 0; ldc = 256; }
        else if (pn < 34) { off = WS_SV; c0 = 0; ldc = 256; }
        else { const int g = (pn - 34) >> 2; off = WS_GATES + (size_t)g * M * D * 2; c0 = (pn - 34) & 3; mode = 2; }
        bf16* dst = (bf16*)(ws + off) + c0 * 256 + wc * 32 + 8 * fq;
#pragma unroll
        for (int ai = 0; ai < 2; ++ai)
#pragma unroll
            for (int m = 0; m < 4; ++m) {
                bf16* rowp = dst + (size_t)(row0 + ai * 128 + m * 16) * ldc;
#pragma unroll
                for (int bj = 0; bj < 2; ++bj) {
                    f32x4 v0 = acc[ai][bj][m][0], v1 = acc[ai][bj][m][1];
                    if (mode == 1) {
#pragma unroll
                        for (int j = 0; j < 4; ++j) { v0[j] = fsilu(v0[j]); v1[j] = fsilu(v1[j]); }
                    } else if (mode == 2) {
#pragma unroll
                        for (int j = 0; j < 4; ++j) { v0[j] = fsigmoid(v0[j]); v1[j] = fsigmoid(v1[j]); }
                    } else if (mode == 3) { v0 = v0 * 0.125f; v1 = v1 * 0.125f; }
                    *(v4u*)(rowp + bj * 128) = pack8(v0, v1);
                }
            }
    }
};
struct EpiMerge {
    static constexpr bool PERM = true, AFTER_DRAIN = false;
    const bf16* gates; float* macc; bf16* merged;
    __device__ __forceinline__ void operator()(const f32x4 (&acc)[2][2][4][2], const Unit& u, int wr, int wc, int fr, int fq) const {
        const int which = u.pn >> 2, pn = u.pn & 3, pm = u.pm & 63;
        const int row0 = pm * 256 + wr * 64 + fr, col0 = pn * 256 + wc * 32 + 8 * fq;
        const bf16* gp = gates + (size_t)which * M * D;
#pragma unroll
        for (int ai = 0; ai < 2; ++ai)
#pragma unroll
            for (int m = 0; m < 4; ++m) {
                const size_t ro = (size_t)(row0 + ai * 128 + m * 16) * D + col0;
#pragma unroll
                for (int bj = 0; bj < 2; ++bj) {
                    const size_t o = ro + bj * 128;
                    const v4u g = *(const v4u*)(gp + o);
                    f32x4 v0 = acc[ai][bj][m][0] * (f32x4){bflo(g.x), bfhi(g.x), bflo(g.y), bfhi(g.y)};
                    f32x4 v1 = acc[ai][bj][m][1] * (f32x4){bflo(g.z), bfhi(g.z), bflo(g.w), bfhi(g.w)};
                    float* mp = macc + o;
                    if (which != 0) { v0 += *(const f32x4*)mp; v1 += *(const f32x4*)(mp + 4); }
                    if (which != 2) { *(f32x4*)mp = v0; *(f32x4*)(mp + 4) = v1; }
                    else *(v4u*)(merged + o) = pack8(v0, v1);
                }
            }
    }
};
struct EpiResid {
    static constexpr bool PERM = true, AFTER_DRAIN = false;
    float* P;
    __device__ __forceinline__ void operator()(const f32x4 (&acc)[2][2][4][2], const Unit& u, int wr, int wc, int fr, int fq) const {
        const int row0 = u.pm * 256 + wr * 64 + fr, col0 = u.pn * 256 + wc * 32 + 8 * fq;
#pragma unroll
        for (int ai = 0; ai < 2; ++ai)
#pragma unroll
            for (int m = 0; m < 4; ++m) {
                float* rp = P + (size_t)(row0 + ai * 128 + m * 16) * D + col0;
#pragma unroll
                for (int bj = 0; bj < 2; ++bj) {
                    float* p = rp + bj * 128;
                    const f32x4 a = *(const f32x4*)p, b = *(const f32x4*)(p + 4);
                    *(f32x4*)p = a * DN_ALPHA + acc[ai][bj][m][0]; *(f32x4*)(p + 4) = b * DN_ALPHA + acc[ai][bj][m][1];
                }
            }
    }
};
struct EpiSwiglu {
    static constexpr bool PERM = true, AFTER_DRAIN = false;
    bf16* H; int ldh, nN;
    __device__ __forceinline__ void operator()(const f32x4 (&acc)[2][2][4][2], const Unit& u, int wr, int wc, int fr, int fq) const {
        const int n = u.pn % nN; const int row0 = u.pm * 256 + wr * 64 + fr, col0 = n * 128 + wc * 32 + 8 * fq;
#pragma unroll
        for (int ai = 0; ai < 2; ++ai)
#pragma unroll
            for (int m = 0; m < 4; ++m) {
                f32x4 v0 = acc[ai][0][m][0], v1 = acc[ai][0][m][1];
#pragma unroll
                for (int j = 0; j < 4; ++j) { v0[j] = fsilu(v0[j]); v1[j] = fsilu(v1[j]); }
                v0 = v0 * acc[ai][1][m][0]; v1 = v1 * acc[ai][1][m][1];
                *(v4u*)(H + (size_t)(row0 + ai * 128 + m * 16) * ldh + col0) = pack8(v0, v1);
            }
    }
};
struct EpiMoeDown {
    static constexpr bool PERM = true, AFTER_DRAIN = false;
    bf16* YS; const int* rowslot; const float* roww;
    __device__ __forceinline__ void operator()(const f32x4 (&acc)[2][2][4][2], const Unit& u, int wr, int wc, int fr, int fq) const {
        const int n = u.pn & 3; const int row0 = u.pm * 256 + wr * 64 + fr, col0 = n * 256 + wc * 32 + 8 * fq;
#pragma unroll
        for (int ai = 0; ai < 2; ++ai)
#pragma unroll
            for (int m = 0; m < 4; ++m) {
                const int r = row0 + ai * 128 + m * 16; const int slot = rowslot[r]; const float w = roww[r];
                if (slot >= 0) {
                    bf16* rp = YS + (size_t)slot * D + col0;
#pragma unroll
                    for (int bj = 0; bj < 2; ++bj) *(v4u*)(rp + bj * 128) = pack8(acc[ai][bj][m][0] * w, acc[ai][bj][m][1] * w);
                }
            }
    }
};
struct MergeOrder {
    pg8::StaticOrder S;
    __device__ bool next(int i, Unit& u) const { const int rnd = i / 3, which = i - 3 * rnd; if (!S.next(rnd, u)) return false; u.pm += which * 64; u.pn += which * 4; return true; }
    __device__ __forceinline__ void a_ready(const Unit&) const {}
    __device__ __forceinline__ void done(const Unit&) const {}
};
struct MoeOrder {
    pg8::StaticOrder S; int pend[NEXP]; int nN;
    __device__ void init(const unsigned* cnt, int nN_, int G, int c) {
        int p = 0;
#pragma unroll
        for (int e = 0; e < NEXP; ++e) { p += ((int)cnt[64 * e] + 255) >> 8; pend[e] = p; }
        nN = nN_; S.init(p * 256, nN_ * 256, G, c);
    }
    __device__ bool next(int i, Unit& u) const {
        if (!S.next(i, u)) return false;
        int e = 0;
#pragma unroll
        for (int k = 0; k < NEXP - 1; ++k) e += (u.pm >= pend[k]) ? 1 : 0;
        u.pn += e * nN; return true;
    }
    __device__ __forceinline__ void a_ready(const Unit&) const {}
    __device__ __forceinline__ void done(const Unit&) const {}
};
__device__ __forceinline__ void transpose_item(const float* W, int ldn, int k0, int n0, bf16* WT, int K, int drow0, LAS float* scr, int lane) {
#pragma unroll 8
    for (int i = 0; i < 32; ++i) { const int kk = 2 * i + (lane >> 5); scr[kk * 33 + (lane & 31)] = W[(size_t)(k0 + kk) * ldn + n0 + (lane & 31)]; }
    LDS_WAIT(); asm volatile("" ::: "memory");
    const int c = lane & 7;
#pragma unroll
    for (int j = 0; j < 4; ++j) { const int n = (lane >> 3) + 8 * j; const LAS float* s = scr + (8 * c) * 33 + n;
        v4u o; o.x = pk2(s[0 * 33], s[1 * 33]); o.y = pk2(s[2 * 33], s[3 * 33]); o.z = pk2(s[4 * 33], s[5 * 33]); o.w = pk2(s[6 * 33], s[7 * 33]);
        *(GAS v4u*)(WT + (size_t)(drow0 + n) * K + k0 + 8 * c) = o; }
    LDS_WAIT(); asm volatile("" ::: "memory");
}
__device__ __forceinline__ int win_row(int s) {
    if (s >= 1024) return s;
    const int which = s >> 9, head = (s & 511) >> 7, d = s & 127, bj = d >> 6, dd = d & 63;
    return (which * 2 + (head >> 1)) * 256 + bj * 128 + (head & 1) * 64 + dd;
}
__device__ __forceinline__ int gu_row(int s, int up) { return 256 * (s >> 7) + (s & 127) + (up ? 128 : 0); }

__device__ __forceinline__ const float* INP(int i) {
    const float* const* p = (const float* const*)__builtin_amdgcn_kernarg_segment_ptr();
    asm volatile("" : "+s"(p));
    return p[i];
}
__device__ __forceinline__ unsigned char* WSP() {
    unsigned char* const* p = (unsigned char* const*)__builtin_amdgcn_kernarg_segment_ptr();
    asm volatile("" : "+s"(p));
    return p[23];
}
struct Args { const float* in[22]; float* out; unsigned char* ws; int ph_lo, ph_hi; };
typedef Args Ptrs;

__device__ __forceinline__ void prologue_convert(LAS float* scr, int gw, int NGW, int lane) {
    constexpr int I_WIN = (D / 64) * (NIN / 32);
    constexpr int I_SQ = (D / 64) * (D / 32);
    constexpr int I_F = (D / 64) * (DFF / 32);
    constexpr int NITEMS = 2 * I_WIN + 8 * I_SQ + 3 * I_F;
    unsigned char* ws = WSP();
    for (int it = gw; it < NITEMS; it += NGW) {
        int r = it;
        if (r < 2 * I_WIN) { const int l = r / I_WIN; r -= l * I_WIN; const int nblk = NIN / 32, kb = r / nblk, nb = r % nblk;
            transpose_item(INP(3) + (size_t)l * D * NIN, NIN, 64 * kb, 32 * nb, (bf16*)(ws + WS_WIN) + (size_t)l * NIN * D, D, win_row(32 * nb), scr, lane); continue; }
        r -= 2 * I_WIN;
        if (r < 8 * I_SQ) { const int mi = r / I_SQ; r -= mi * I_SQ; const int l = mi >> 2, w = mi & 3;
            const float* src = (w == 0 ? INP(4) : w == 1 ? INP(7) : w == 2 ? INP(9) : INP(10)) + (size_t)l * D * D;
            bf16* dst = (bf16*)(ws + WS_WOUT + (size_t)l * 8 * MiB) + (size_t)w * D * D;
            const int kb = r / 32, nb = r % 32; transpose_item(src, D, 64 * kb, 32 * nb, dst, D, 32 * nb, scr, lane); continue; }
        r -= 8 * I_SQ;
        if (r < 2 * I_F) { const int up = r / I_F; r -= up * I_F; const int nblk = DFF / 32, kb = r / nblk, nb = r % nblk;
            transpose_item(up ? INP(14) : INP(13), DFF, 64 * kb, 32 * nb, (bf16*)(ws + WS_WGU), D, gu_row(32 * nb, up), scr, lane); continue; }
        r -= 2 * I_F;
        { const int kb = r / 32, nb = r % 32; transpose_item(INP(15), D, 64 * kb, 32 * nb, (bf16*)(ws + WS_WDN), DFF, 32 * nb, scr, lane); }
    }
}
__device__ __forceinline__ void moe_convert(LAS float* scr, int gw, int NGW, int lane) {
    constexpr int I_E = (D / 64) * (DEXP / 32);
    unsigned char* ws = WSP();
    for (int it = gw; it < 24 * I_E; it += NGW) {
        const int mi = it / I_E, r = it - mi * I_E, kind = mi >> 3, e = mi & 7;
        if (kind < 2) { const int nblk = DEXP / 32, kb = r / nblk, nb = r % nblk;
            transpose_item((kind ? INP(18) : INP(17)) + (size_t)e * D * DEXP, DEXP, 64 * kb, 32 * nb, (bf16*)(ws + WS_WGUE) + (size_t)e * 2 * DEXP * D, D, gu_row(32 * nb, kind), scr, lane); }
        else { const int kb = r / 32, nb = r % 32;
            transpose_item(INP(19) + (size_t)e * DEXP * D, D, 64 * kb, 32 * nb, (bf16*)(ws + WS_WDNE) + (size_t)e * D * DEXP, DEXP, 32 * nb, scr, lane); }
    }
}
__device__ __forceinline__ void ln_core(f32x4 (&v)[4], const float* g, const float* b, int lane) {
    float s = 0.f;
#pragma unroll
    for (int j = 0; j < 4; ++j) s += (v[j][0] + v[j][1]) + (v[j][2] + v[j][3]);
    const float mean = wave_sum(s) * (1.f / D); float s2 = 0.f;
#pragma unroll
    for (int j = 0; j < 4; ++j) { v[j] = v[j] - mean; s2 += (v[j][0] * v[j][0] + v[j][1] * v[j][1]) + (v[j][2] * v[j][2] + v[j][3] * v[j][3]); }
    const float rstd = 1.f / sqrtf(wave_sum(s2) * (1.f / D) + LN_EPS);
#pragma unroll
    for (int j = 0; j < 4; ++j) { const f32x4 gg = *(const f32x4*)(g + 4 * lane + 256 * j), bb = *(const f32x4*)(b + 4 * lane + 256 * j); v[j] = v[j] * rstd * gg + bb; }
}
__device__ __forceinline__ void store_row_f32(float* dst, const f32x4 (&v)[4], int lane) {
#pragma unroll
    for (int j = 0; j < 4; ++j) *(f32x4*)(dst + 4 * lane + 256 * j) = v[j];
}
__device__ __forceinline__ void store_row_bf16(bf16* dst, const f32x4 (&v)[4], int lane) {
#pragma unroll
    for (int j = 0; j < 4; ++j) { v2u w; w.x = pk2(v[j][0], v[j][1]); w.y = pk2(v[j][2], v[j][3]); *(v2u*)(dst + 4 * lane + 256 * j) = w; }
}
__device__ __forceinline__ void ret_seq(unsigned char* ws, int item, LAS float* sm, int tid) {
    const int b = item >> 2, h = item & 3, dv = tid & 255, kh = tid >> 8, wave = tid >> 6, lane = tid & 63;
    const float gamma = 1.f - exp2f(-5.f - (float)h);
    const bf16* RQ = (const bf16*)(ws + WS_RQ); const bf16* RK = (const bf16*)(ws + WS_RK); const bf16* RV = (const bf16*)(ws + WS_RV); bf16* RG = (bf16*)(ws + WS_OABC);
    LAS float* qs = sm; LAS float* ks = sm + 2048; LAS float* part = sm + 4096;
    float S[64];
#pragma unroll
    for (int i = 0; i < 64; ++i) S[i] = 0.f;
    for (int c0 = 0; c0 < SEQ; c0 += 16) {
        const size_t row0 = (size_t)b * SEQ + c0;
        for (int i = tid; i < 2048; i += 512) { const int t = i >> 7, d = i & 127; qs[i] = bf2f(RQ[(row0 + t) * 512 + h * 128 + d]); ks[i] = bf2f(RK[(row0 + t) * 512 + h * 128 + d]); }
        __syncthreads();
        for (int t = 0; t < 16; ++t) {
            const float v = bf2f(RV[(row0 + t) * 1024 + h * 256 + dv]); float po = 0.f;
            const LAS float* kp = ks + t * 128 + kh * 64; const LAS float* qp = qs + t * 128 + kh * 64;
#pragma unroll
            for (int i = 0; i < 64; ++i) { S[i] = gamma * S[i] + kp[i] * v; po += qp[i] * S[i]; }
            part[(t * 2 + kh) * 256 + dv] = po;
        }
        __syncthreads();
#pragma unroll
        for (int tt = 0; tt < 2; ++tt) {
            const int t = 2 * wave + tt; float o[4]; float ss = 0.f;
#pragma unroll
            for (int j = 0; j < 4; ++j) { o[j] = part[(t * 2) * 256 + lane * 4 + j] + part[(t * 2 + 1) * 256 + lane * 4 + j]; ss += o[j] * o[j]; }
            const float rstd = 1.f / sqrtf(wave_sum(ss) * (1.f / 256.f) + RMS_EPS);
            bf16* gp = RG + (row0 + t) * 1024 + h * 256 + lane * 4; const v2u g = *(const v2u*)gp;
            v2u w; w.x = pk2(o[0] * rstd * bflo(g.x), o[1] * rstd * bfhi(g.x)); w.y = pk2(o[2] * rstd * bflo(g.y), o[3] * rstd * bfhi(g.y));
            *(v2u*)gp = w;
        }
        __syncthreads();
    }
}
__device__ __forceinline__ void hgrn_seq(unsigned char* ws, const float* lb, const float* ng, int item, LAS float* sm, int tid) {
    const int b = item >> 3, h = item & 7, dv = tid & 127, kq = tid >> 7, wave = tid >> 6, lane = tid & 63;
    const bf16* HQ = (const bf16*)(ws + WS_HQ); const bf16* HF = (const bf16*)(ws + WS_HF); const bf16* HI = (const bf16*)(ws + WS_HI); bf16* HG = (bf16*)(ws + WS_OABC) + (size_t)M * D;
    LAS float* fs = sm; LAS float* qs = sm + 2048; LAS float* part = sm + 4096;
    float S[32];
#pragma unroll
    for (int i = 0; i < 32; ++i) S[i] = 0.f;
    for (int c0 = 0; c0 < SEQ; c0 += 16) {
        const size_t row0 = (size_t)b * SEQ + c0;
        for (int i = tid; i < 2048; i += 512) { const int t = i >> 7, d = i & 127; const float z = bf2f(HF[(row0 + t) * 1024 + h * 128 + d]); const float l = lb ? lb[h * 128 + d] : 0.f;
            fs[i] = l + (1.f - l) * fsigmoid(z); qs[i] = bf2f(HQ[(row0 + t) * 1024 + h * 128 + d]); }
        __syncthreads();
        for (int t = 0; t < 16; ++t) {
            const float v = bf2f(HI[(row0 + t) * 1024 + h * 128 + dv]); float po = 0.f;
            const LAS float* fp = fs + t * 128 + kq * 32; const LAS float* qp = qs + t * 128 + kq * 32;
#pragma unroll
            for (int i = 0; i < 32; ++i) { const float f = fp[i]; S[i] = f * S[i] + (1.f - f) * v; po += qp[i] * S[i]; }
            part[(t * 4 + kq) * 128 + dv] = po;
        }
        __syncthreads();
#pragma unroll
        for (int tt = 0; tt < 2; ++tt) {
            const int t = 2 * wave + tt; float o[2]; float ss = 0.f;
#pragma unroll
            for (int j = 0; j < 2; ++j) { const int c = lane * 2 + j; o[j] = (part[(t * 4) * 128 + c] + part[(t * 4 + 1) * 128 + c]) + (part[(t * 4 + 2) * 128 + c] + part[(t * 4 + 3) * 128 + c]); ss += o[j] * o[j]; }
            const float rstd = 1.f / sqrtf(wave_sum(ss) * (1.f / 128.f) + RMS_EPS);
            bf16* gp = HG + (row0 + t) * 1024 + h * 128 + lane * 2; const unsigned g = *(const unsigned*)gp;
            *(unsigned*)gp = pk2(o[0] * rstd * ng[lane * 2] * bflo(g), o[1] * rstd * ng[lane * 2 + 1] * bfhi(g));
        }
        __syncthreads();
    }
}
__device__ __forceinline__ void swa_seq(unsigned char* ws, const float* sinks, int item, int lane) {
    const int hq = item & 15, c = (item >> 4) & 31, b = item >> 9, kvh = hq >> 2;
    bf16* SQ = (bf16*)(ws + WS_OABC) + (size_t)2 * M * D; const bf16* SK = (const bf16*)(ws + WS_SK); const bf16* SV = (const bf16*)(ws + WS_SV);
    bf16* qp = SQ + ((size_t)b * SEQ + c * 64 + lane) * 1024 + hq * 64;
    float q[64], o[64];
#pragma unroll
    for (int i = 0; i < 8; ++i) { const v4u w = *(const v4u*)(qp + 8 * i);
        q[8 * i] = bflo(w.x); q[8 * i + 1] = bfhi(w.x); q[8 * i + 2] = bflo(w.y); q[8 * i + 3] = bfhi(w.y); q[8 * i + 4] = bflo(w.z); q[8 * i + 5] = bfhi(w.z); q[8 * i + 6] = bflo(w.w); q[8 * i + 7] = bfhi(w.w); }
#pragma unroll
    for (int i = 0; i < 64; ++i) o[i] = 0.f;
    float mx = sinks[hq], l = 1.f;
    const int s0 = (c >= 2 ? c - 2 : 0) * 64, s1 = c * 64 + 64;
    for (int s = s0; s < s1; ++s) {
        const bf16* kp = SK + ((size_t)b * SEQ + s) * 256 + kvh * 64; const bf16* vp = SV + ((size_t)b * SEQ + s) * 256 + kvh * 64;
        float sc = 0.f;
#pragma unroll
        for (int i = 0; i < 8; ++i) { const v4u w = *(const v4u*)(kp + 8 * i);
            sc += q[8 * i] * bflo(w.x) + q[8 * i + 1] * bfhi(w.x) + q[8 * i + 2] * bflo(w.y) + q[8 * i + 3] * bfhi(w.y) + q[8 * i + 4] * bflo(w.z) + q[8 * i + 5] * bfhi(w.z) + q[8 * i + 6] * bflo(w.w) + q[8 * i + 7] * bfhi(w.w); }
        const float mn = fmaxf(mx, sc), a = __expf(mx - mn), p = __expf(sc - mn); mx = mn; l = l * a + p;
#pragma unroll
        for (int i = 0; i < 8; ++i) { const v4u w = *(const v4u*)(vp + 8 * i);
            o[8 * i] = o[8 * i] * a + p * bflo(w.x); o[8 * i + 1] = o[8 * i + 1] * a + p * bfhi(w.x); o[8 * i + 2] = o[8 * i + 2] * a + p * bflo(w.y); o[8 * i + 3] = o[8 * i + 3] * a + p * bfhi(w.y);
            o[8 * i + 4] = o[8 * i + 4] * a + p * bflo(w.z); o[8 * i + 5] = o[8 * i + 5] * a + p * bfhi(w.z); o[8 * i + 6] = o[8 * i + 6] * a + p * bflo(w.w); o[8 * i + 7] = o[8 * i + 7] * a + p * bfhi(w.w); }
    }
    const float inv = 1.f / l;
#pragma unroll
    for (int i = 0; i < 8; ++i) { v4u w; w.x = pk2(o[8 * i] * inv, o[8 * i + 1] * inv); w.y = pk2(o[8 * i + 2] * inv, o[8 * i + 3] * inv); w.z = pk2(o[8 * i + 4] * inv, o[8 * i + 5] * inv); w.w = pk2(o[8 * i + 6] * inv, o[8 * i + 7] * inv);
        *(v4u*)(qp + 8 * i) = w; }
}
#ifndef MK_PHMASK
#define MK_PHMASK 0x3ff
#endif
#define PHEN(j) (((MK_PHMASK) >> (j)) & 1)
constexpr int NPHASES = 19;
#define PHASE_IDS() int tid = threadIdx.x; asm volatile("" : "+v"(tid)); const int lane = tid & 63, wave = __builtin_amdgcn_readfirstlane(tid >> 6); const int gw = vcu * NWAVES + wave; (void)lane; (void)gw
__global__ void __launch_bounds__(NWAVES * 64, 2) mk_fwd(Args args) {
    extern __shared__ __attribute__((aligned(16))) unsigned char lds_raw[];
    LAS unsigned char* lds = (LAS unsigned char*)lds_raw;
    volatile LAS unsigned* MISC = (volatile LAS unsigned*)(lds + MISC_OFF);
    const int G = gridDim.x; const int bx = blockIdx.x;
    const int vcu = (G % 8 == 0) ? (bx % 8) * (G / 8) + bx / 8 : bx;
    const int NGW = G * NWAVES;
    unsigned char* ws = args.ws;
    gu32* ctl = (gu32*)(ws + WS_CTL);
    for (int u = threadIdx.x; u < (LDS_BYTES - LDSCTL_OFF) / 4; u += NWAVES * 64) ((LAS unsigned*)(lds + LDSCTL_OFF))[u] = 0u;
    __syncthreads();
    const int lo = args.ph_lo, hi = args.ph_hi;
    XcdBarrier bar; bar.bar = (unsigned*)(ctl + CW_BAR); bar.x = 0; bar.st = nullptr;
    if (hi - lo > 1) bar = xcd_barrier_post((unsigned*)(ctl + CW_BAR), MISC + 8);
#define IN(k) (lo <= (k) && (k) < hi)
#define SEAM(k) do { if (IN(k) && IN((k) + 1)) xcd_barrier(bar); } while (0)
    float* Hf = args.out;
    bf16* Hb = (bf16*)(ws + WS_HBF);

    if (PHEN(9) && IN(0)) { PHASE_IDS();
        LAS float* scrw = (LAS float*)(lds + RING_OFF + wave * 16384); prologue_convert(scrw, gw, NGW, lane);
        for (int m = gw; m < M; m += NGW) {
            f32x4 v[4];
#pragma unroll
            for (int j = 0; j < 4; ++j) v[j] = *(const f32x4*)(INP(0) + (size_t)m * D + 4 * lane + 256 * j);
            ln_core(v, INP(1), INP(2), lane);
            store_row_f32(Hf + (size_t)m * D, v, lane); store_row_bf16(Hb + (size_t)m * D, v, lane);
        }
        const int gt = vcu * NWAVES * 64 + tid, NGT = G * NWAVES * 64;
        for (int i = gt; i < SEQ * 64; i += NGT) {
            const int t = i >> 6, dd = i & 63;
            const float inv = (float)exp(-9.210340371976184 * ((double)dd / 63.0));
            const float ang = (float)t * inv;
            ((f32x2*)(ws + WS_ROPE))[i] = (f32x2){(float)cos((double)ang), (float)sin((double)ang)};
        }
        for (int i = gt; i < D; i += NGT) {
            const float p0 = INP(5)[i], p1 = INP(5)[D + i];
            ((float*)(ws + WS_LB))[i] = 1.f / (1.f + expf(p0 - p1));
        }
        for (int i = gt; i < MOE_ROWS; i += NGT) ((int*)(ws + WS_RSLOT))[i] = -1;
    }
    SEAM(0);

    for (int l = 0; l < 2; ++l) {
        const int pb = 1 + 9 * l;
        const bf16* Win = (const bf16*)(ws + WS_WIN) + (size_t)l * NIN * D;
        const bf16* Wout = (const bf16*)(ws + WS_WOUT + (size_t)l * 8 * MiB);
        if (PHEN(0) && IN(pb + 0)) { PHASE_IDS();
            pg8::Gemm g{Hb, Win, M, NIN, D}; pg8::StaticOrder S; S.init(M, NIN, G, bx);
            EpiProj E{ws, (const f32x4*)(ws + WS_ROPE)};
            pg8::gemm_phase<EpiProj, pg8::StaticOrder, PG8_ALIGN, PG8_SP2>(lds + RING_OFF, g, S, E);
        }
        SEAM(pb + 0);
        if (PHEN(1) && IN(pb + 1)) { PHASE_IDS();
            for (int vb = bx; vb < 256; vb += G) {
                if (vb < 32) {
#ifndef NO_RET
                    ret_seq(ws, vb, (LAS float*)(lds + RING_OFF), tid);
#endif
                } else if (vb < 96) {
#ifndef NO_HGRN
                    hgrn_seq(ws, l ? (const float*)(ws + WS_LB) : nullptr, INP(6) + l * 128, vb - 32, (LAS float*)(lds + RING_OFF), tid);
#endif
                } else {
#ifndef NO_SWA
                    for (int it = (vb - 96) * NWAVES + wave; it < 4096; it += 160 * NWAVES) swa_seq(ws, INP(8) + l * 16, it, lane);
#endif
                }
            }
        }
        SEAM(pb + 1);
        if (PHEN(2) && IN(pb + 2)) { PHASE_IDS();
            pg8::Gemm g{(const bf16*)(ws + WS_OABC), Wout, 3 * M, 3 * D, D}; MergeOrder S; S.S.init(M, D, G, bx);
            EpiMerge E{(const bf16*)(ws + WS_GATES), (float*)(ws + WS_MACC), (bf16*)(ws + WS_MERGED)};
            pg8::gemm_phase<EpiMerge, MergeOrder, PG8_ALIGN, PG8_SP2>(lds + RING_OFF, g, S, E);
        }
        SEAM(pb + 2);
        if (PHEN(3) && IN(pb + 3)) { PHASE_IDS();
            pg8::Gemm g{(const bf16*)(ws + WS_MERGED), Wout + (size_t)3 * D * D, M, D, D}; pg8::StaticOrder S; S.init(M, D, G, bx);
            EpiResid E{Hf};
            pg8::gemm_phase<EpiResid, pg8::StaticOrder, PG8_ALIGN, PG8_SP2>(lds + RING_OFF, g, S, E);
            if (l == 1) { __syncthreads(); LAS float* scrw = (LAS float*)(lds + RING_OFF + wave * 16384); moe_convert(scrw, gw, NGW, lane); }
        }
        SEAM(pb + 3);
        if (PHEN(4) && IN(pb + 4)) { PHASE_IDS();
            const float* g_ = INP(11) + l * D; const float* b_ = INP(12) + l * D;
            for (int m = gw; m < M; m += NGW) {
                f32x4 v[4];
#pragma unroll
                for (int j = 0; j < 4; ++j) v[j] = *(const f32x4*)(Hf + (size_t)m * D + 4 * lane + 256 * j);
                ln_core(v, g_, b_, lane);
                store_row_f32(Hf + (size_t)m * D, v, lane); store_row_bf16(Hb + (size_t)m * D, v, lane);
                if (l == 1) {
                    float lg[NEXP];
#pragma unroll
                    for (int e = 0; e < NEXP; ++e) lg[e] = 0.f;
                    const float* wr_ = INP(16);
#pragma unroll
                    for (int j = 0; j < 4; ++j)
#pragma unroll
                        for (int q = 0; q < 4; ++q) { const float* wp = wr_ + (size_t)(4 * lane + 256 * j + q) * NEXP; const f32x4 w0 = *(const f32x4*)wp, w1 = *(const f32x4*)(wp + 4); const float x = v[j][q];
                            lg[0] += x * w0[0]; lg[1] += x * w0[1]; lg[2] += x * w0[2]; lg[3] += x * w0[3]; lg[4] += x * w1[0]; lg[5] += x * w1[1]; lg[6] += x * w1[2]; lg[7] += x * w1[3]; }
#pragma unroll
                    for (int e = 0; e < NEXP; ++e) lg[e] = wave_sum(lg[e]);
                    int e0 = 0; float l0 = lg[0];
#pragma unroll
                    for (int e = 1; e < NEXP; ++e) if (lg[e] > l0) { l0 = lg[e]; e0 = e; }
                    int e1 = -1; float l1 = -3.0e38f;
#pragma unroll
                    for (int e = 0; e < NEXP; ++e) if (e != e0 && lg[e] > l1) { l1 = lg[e]; e1 = e; }
                    if (lane == 0) {
                        const float p1 = __expf(l1 - l0), w0 = 1.f / (1.f + p1), w1 = p1 * w0;
                        const int pos0 = (int)__hip_atomic_fetch_add(ctl + CW_ECNT + 64 * e0, 1u, RLX_AGENT), pos1 = (int)__hip_atomic_fetch_add(ctl + CW_ECNT + 64 * e1, 1u, RLX_AGENT);
                        ((int*)(ws + WS_TOKI))[4 * m + 0] = e0; ((int*)(ws + WS_TOKI))[4 * m + 1] = pos0; ((int*)(ws + WS_TOKI))[4 * m + 2] = e1; ((int*)(ws + WS_TOKI))[4 * m + 3] = pos1;
                        ((float*)(ws + WS_TOKW))[2 * m] = w0; ((float*)(ws + WS_TOKW))[2 * m + 1] = w1;
                    }
                }
            }
        }
        SEAM(pb + 4);
        if (l == 0) {
            if (PHEN(6) && IN(pb + 6)) { PHASE_IDS();
                pg8::Gemm g{Hb, (const bf16*)(ws + WS_WGU), M, 2 * DFF, D}; pg8::StaticOrder S; S.init(M, 2 * DFF, G, bx);
                EpiSwiglu E{(bf16*)(ws + WS_HID), DFF, 2 * DFF / 256};
                pg8::gemm_phase<EpiSwiglu, pg8::StaticOrder, PG8_ALIGN, PG8_SP2>(lds + RING_OFF, g, S, E);
            }
            SEAM(pb + 6);
            if (PHEN(7) && IN(pb + 7)) { PHASE_IDS();
                pg8::Gemm g{(const bf16*)(ws + WS_HID), (const bf16*)(ws + WS_WDN), M, D, DFF}; pg8::StaticOrder S; S.init(M, D, G, bx);
                EpiResid E{Hf};
                pg8::gemm_phase<EpiResid, pg8::StaticOrder, PG8_ALIGN, PG8_SP2>(lds + RING_OFF, g, S, E);
            }
            SEAM(pb + 7);
            if (PHEN(8) && IN(pb + 8)) { PHASE_IDS();
                const float* g_ = INP(20); const float* b_ = INP(21);
                for (int m = gw; m < M; m += NGW) {
                    f32x4 v[4];
#pragma unroll
                    for (int j = 0; j < 4; ++j) v[j] = *(const f32x4*)(Hf + (size_t)m * D + 4 * lane + 256 * j);
                    ln_core(v, g_, b_, lane);
                    store_row_f32(Hf + (size_t)m * D, v, lane); store_row_bf16(Hb + (size_t)m * D, v, lane);
                }
            }
            SEAM(pb + 8);
        } else {
            const unsigned* ecnt = (const unsigned*)(ctl + CW_ECNT);
            if (PHEN(5) && IN(pb + 5)) { PHASE_IDS();
                int offs[NEXP]; { int p = 0;
#pragma unroll
                    for (int e = 0; e < NEXP; ++e) { offs[e] = p * 256; p += ((int)ecnt[64 * e] + 255) >> 8; } }
                for (int m = gw; m < M; m += NGW) {
                    const int e0 = ((const int*)(ws + WS_TOKI))[4 * m + 0], p0 = ((const int*)(ws + WS_TOKI))[4 * m + 1], e1 = ((const int*)(ws + WS_TOKI))[4 * m + 2], p1 = ((const int*)(ws + WS_TOKI))[4 * m + 3];
                    int r0 = 0, r1 = 0;
#pragma unroll
                    for (int e = 0; e < NEXP; ++e) { if (e == e0) r0 = offs[e] + p0; if (e == e1) r1 = offs[e] + p1; }
                    const v4u a = *(const v4u*)(Hb + (size_t)m * D + 8 * lane), c = *(const v4u*)(Hb + (size_t)m * D + 512 + 8 * lane);
                    bf16* x0 = (bf16*)(ws + WS_XS) + (size_t)r0 * D; bf16* x1 = (bf16*)(ws + WS_XS) + (size_t)r1 * D;
                    *(v4u*)(x0 + 8 * lane) = a; *(v4u*)(x0 + 512 + 8 * lane) = c; *(v4u*)(x1 + 8 * lane) = a; *(v4u*)(x1 + 512 + 8 * lane) = c;
                    if (lane == 0) { ((int*)(ws + WS_RSLOT))[r0] = 2 * m; ((int*)(ws + WS_RSLOT))[r1] = 2 * m + 1;
                        ((float*)(ws + WS_RW))[r0] = ((const float*)(ws + WS_TOKW))[2 * m]; ((float*)(ws + WS_RW))[r1] = ((const float*)(ws + WS_TOKW))[2 * m + 1]; }
                }
            }
            SEAM(pb + 5);
            if (PHEN(6) && IN(pb + 6)) { PHASE_IDS();
                pg8::Gemm g{(const bf16*)(ws + WS_XS), (const bf16*)(ws + WS_WGUE), MOE_ROWS, NEXP * 2 * DEXP, D}; MoeOrder S; S.init(ecnt, 2 * DEXP / 256, G, bx);
                EpiSwiglu E{(bf16*)(ws + WS_HIDE), DEXP, 2 * DEXP / 256};
                pg8::gemm_phase<EpiSwiglu, MoeOrder, PG8_ALIGN, PG8_SP2>(lds + RING_OFF, g, S, E);
            }
            SEAM(pb + 6);
            if (PHEN(7) && IN(pb + 7)) { PHASE_IDS();
                pg8::Gemm g{(const bf16*)(ws + WS_HIDE), (const bf16*)(ws + WS_WDNE), MOE_ROWS, NEXP * D, DEXP}; MoeOrder S; S.init(ecnt, D / 256, G, bx);
                EpiMoeDown E{(bf16*)(ws + WS_YS), (const int*)(ws + WS_RSLOT), (const float*)(ws + WS_RW)};
                pg8::gemm_phase<EpiMoeDown, MoeOrder, PG8_ALIGN, PG8_SP2>(lds + RING_OFF, g, S, E);
            }
            SEAM(pb + 7);
            if (PHEN(8) && IN(pb + 8)) { PHASE_IDS();
                const float* g_ = INP(20) + D; const float* b_ = INP(21) + D; const bf16* YS = (const bf16*)(ws + WS_YS);
                for (int m = gw; m < M; m += NGW) {
                    f32x4 v[4];
#pragma unroll
                    for (int j = 0; j < 4; ++j) {
                        const f32x4 h = *(const f32x4*)(Hf + (size_t)m * D + 4 * lane + 256 * j);
                        const v2u y0 = *(const v2u*)(YS + (size_t)(2 * m) * D + 4 * lane + 256 * j), y1 = *(const v2u*)(YS + (size_t)(2 * m + 1) * D + 4 * lane + 256 * j);
                        const f32x4 a = (f32x4){bflo(y0.x), bfhi(y0.x), bflo(y0.y), bfhi(y0.y)}, c = (f32x4){bflo(y1.x), bfhi(y1.x), bflo(y1.y), bfhi(y1.y)};
                        v[j] = h * DN_ALPHA + (a + c);
                    }
                    ln_core(v, g_, b_, lane);
                    store_row_f32(Hf + (size_t)m * D, v, lane);
                }
            }
        }
    }
#undef IN
#undef SEAM
}

extern "C" void kernel_launch(void* const* d_in, const int* in_sizes, int n_in, void* d_out, int out_size, void* d_ws, size_t ws_size, hipStream_t stream) {
    static int grid = 0;
    if (grid == 0) {
        if (n_in != 22 || out_size != M * D || ws_size < WS_END) { fprintf(stderr, "kernel_launch: unexpected problem shape (n_in %d, out %d, ws %zu); nothing launched\n", n_in, out_size, ws_size); grid = -1; return; }
        int dev = 0, cus = 0, per_cu = 0;
        if (hipGetDevice(&dev) != hipSuccess || hipDeviceGetAttribute(&cus, hipDeviceAttributeMultiprocessorCount, dev) != hipSuccess) { grid = -1; return; }
        if (hipFuncSetAttribute((const void*)mk_fwd, hipFuncAttributeMaxDynamicSharedMemorySize, LDS_BYTES) != hipSuccess) { fprintf(stderr, "kernel_launch: hipFuncSetAttribute failed\n"); grid = -1; return; }
        if (hipOccupancyMaxActiveBlocksPerMultiprocessor(&per_cu, (const void*)mk_fwd, NWAVES * 64, LDS_BYTES) != hipSuccess || per_cu < 1) { fprintf(stderr, "kernel_launch: occupancy query says %d\n", per_cu); }
        (void)hipGetLastError();
        grid = cus;
    }
    if (grid < 0) return;
    if (hipMemsetAsync((char*)d_ws + WS_CTL, 0, CTL_ZERO_BYTES, stream) != hipSuccess) return;
    Args a{};
    for (int i = 0; i < 22; ++i) a.in[i] = (const float*)d_in[i];
    a.out = (float*)d_out; a.ws = (unsigned char*)d_ws;
#if MK_SINGLE
    a.ph_lo = 0; a.ph_hi = NPHASES;
    hipLaunchKernelGGL(mk_fwd, dim3(grid), dim3(NWAVES * 64), LDS_BYTES, stream, a);
#else
    for (int p = 0; p < NPHASES; ++p) {
        if (p == 6) continue;
        a.ph_lo = p; a.ph_hi = p + 1;
        hipLaunchKernelGGL(mk_fwd, dim3(grid), dim3(NWAVES * 64), LDS_BYTES, stream, a);
    }
#endif
}
```

```cpp
#include <hip/hip_runtime.h>
#include <cstdio>
#include <cstdint>
#ifndef MK_SINGLE
#define MK_SINGLE 1
#endif
#ifndef MIX_SWA_MFMA
#define MIX_SWA_MFMA 1
#endif
#ifndef MIX_RET_MFMA
#define MIX_RET_MFMA 1
#endif
#ifndef MIX_HGRN_MFMA
#define MIX_HGRN_MFMA 1
#endif
namespace pg8 {
#define PG8_LAS __attribute__((address_space(3)))
typedef unsigned short bf16_t;
typedef short bf16x8 __attribute__((ext_vector_type(8)));
typedef float f32x4 __attribute__((ext_vector_type(4)));
typedef unsigned u32x4 __attribute__((ext_vector_type(4)));
constexpr int BM = 256, BK = 64, HALF = 128, HTB = HALF * BK * 2  , STAGE_BYTES = 8 * HTB, NXCD = 8, WGM = 8;

__host__ __device__ __forceinline__ int lds_byte(int r, int c) { const int st = (r >> 4) * 2 + (c >> 5), rr = r & 15, cc = c & 31, ob = rr * 64 + cc * 2; return st * 1024 + (ob ^ (((ob >> 9) & 1) << 5)); }
__host__ __device__ __forceinline__ void stage_rc(int b, int& R, int& C) { const int st = b / 1024, sb = b % 1024, swz = sb ^ (((sb >> 9) & 1) << 5); R = (st >> 1) * 16 + swz / 64; C = (st & 1) * 32 + (swz % 64) / 2; }
__host__ __device__ __forceinline__ int perm32(int rho) { const int n = rho >> 4, i = rho & 15; return 8 * (i >> 2) + 4 * n + (i & 3); }

struct Unit { int pm, pn; };
struct Gemm { const bf16_t* A; const bf16_t* Bt; int M, N, K; };

struct StaticOrder {
    int nM, nN, nwg, G, c;
    __host__ __device__ void init(int M, int N, int G_, int c_) { nM = M / BM; nN = N / BM; nwg = nM * nN; G = G_; c = c_; }
    __host__ __device__ bool next(int i, Unit& u) const {
        const long L = (long)i * G + c; if (L >= nwg) return false;
        int wgid = (int)L; { const int q = nwg / NXCD, r = nwg % NXCD, xcd = wgid % NXCD, off = wgid / NXCD; wgid = (xcd < r ? xcd * (q + 1) : r * (q + 1) + (xcd - r) * q) + off; }
        const int nig = WGM * nN, gid = wgid / nig, fm = gid * WGM, gsz = (nM - fm) < WGM ? (nM - fm) : WGM;
        u.pm = fm + ((wgid % nig) % gsz); u.pn = (wgid % nig) / gsz; return true;
    }
    __device__ __forceinline__ void a_ready(const Unit&) const {}
    __device__ __forceinline__ void done(const Unit&) const {}
};
__device__ __forceinline__ unsigned cvt_pk_bf16(float lo, float hi) { unsigned r; asm volatile("v_cvt_pk_bf16_f32 %0, %1, %2" : "=v"(r) : "v"(lo), "v"(hi)); return r; }
typedef float f32x2 __attribute__((ext_vector_type(2)));
template <class Epi, class Sched, bool ALIGN_EPI = false, bool SP2 = false>
__device__ __forceinline__ void gemm_phase(PG8_LAS unsigned char* lds, const Gemm g, const Sched& S, const Epi& E) {
    int tid_ = threadIdx.x; asm volatile("" : "+v"(tid_));
    const int tid = tid_, wid = __builtin_amdgcn_readfirstlane(tid >> 6), lane = tid & 63, wr = wid >> 2, wc = wid & 3, fr = lane & 15, fq = lane >> 4;
    const int K = g.K, nt = K / BK;
    unsigned voffA[2], voffB[2];
#pragma unroll
    for (int i = 0; i < 2; ++i) { int R, C; stage_rc(tid * 16 + i * 8192, R, C); const int Rb = Epi::PERM ? ((R & ~31) + perm32(R & 31)) : R;
        voffA[i] = (unsigned)(R * K + C) * 2u; voffB[i] = (unsigned)(Rb * K + C) * 2u; }
    const size_t kstep = (size_t)(BK * 2);
    const size_t hstep = (size_t)HALF * K * 2;
    const size_t tstep = 2 * hstep;
    const unsigned ldsw = (unsigned)wid * 1024u;
    const int aoff = lds_byte(wr * 64 + fr, fq * 8), boff = lds_byte(wc * 32 + fr, fq * 8);
#define PG8_SA(b, h) (((b) * 2 + (h)) * HTB)
#define PG8_SB(b, h) ((4 + (b) * 2 + (h)) * HTB)
#define PG8_STAGE(bufoff, gbase, voff) do { _Pragma("unroll") for (int _i = 0; _i < 2; ++_i) \
        __builtin_amdgcn_global_load_lds((const unsigned*)((const char*)(gbase) + (voff)[_i]), (PG8_LAS unsigned*)(lds + (bufoff) + ldsw + _i * 8192), 16, 0, 0); } while (0)
#define PG8_LDA(dst, b, h) do { _Pragma("unroll") for (int m = 0; m < 4; ++m) _Pragma("unroll") for (int k = 0; k < 2; ++k) dst[m][k] = *(const PG8_LAS bf16x8*)(lds + PG8_SA(b, h) + aoff + m * 2048 + k * 1024); } while (0)
#define PG8_LDB(dst, b, h) do { _Pragma("unroll") for (int n = 0; n < 2; ++n) _Pragma("unroll") for (int k = 0; k < 2; ++k) dst[n][k] = *(const PG8_LAS bf16x8*)(lds + PG8_SB(b, h) + boff + n * 2048 + k * 1024); } while (0)
#define PG8_MMA(ai, bj, At, Bt) do { __builtin_amdgcn_s_setprio(1); _Pragma("unroll") for (int m = 0; m < 4; ++m) _Pragma("unroll") for (int n = 0; n < 2; ++n) _Pragma("unroll") for (int k = 0; k < 2; ++k) \
        acc[ai][bj][m][n] = __builtin_amdgcn_mfma_f32_16x16x32_bf16(Bt[n][k], At[m][k], acc[ai][bj][m][n], 0, 0, 0); __builtin_amdgcn_s_setprio(0); } while (0)
#define PG8_WAIT_V(n) asm volatile("s_waitcnt vmcnt(" #n ")" ::: "memory")
#define PG8_WAIT_L(n) asm volatile("s_waitcnt lgkmcnt(" #n ")" ::: "memory")
#define PG8_BAR __builtin_amdgcn_s_barrier()
#define PG8_SCHED __builtin_amdgcn_sched_barrier(0)
    Unit cur, nxt; int ui = 0;
    if (!S.next(0, cur)) return;
    f32x4 acc[2][2][4][2];
#pragma unroll
    for (int a = 0; a < 2; ++a)
#pragma unroll
        for (int b = 0; b < 2; ++b)
#pragma unroll
            for (int m = 0; m < 4; ++m)
#pragma unroll
                for (int n = 0; n < 2; ++n) acc[a][b][m][n] = (f32x4){0.f, 0.f, 0.f, 0.f};
    bf16x8 At[4][2], B0[2][2], B1[2][2];
    const char* cA = (const char*)g.A + (size_t)cur.pm * tstep; const char* cB = (const char*)g.Bt + (size_t)cur.pn * tstep;
    S.a_ready(cur);
    if constexpr (SP2) {
        PG8_STAGE(PG8_SB(0, 0), cB, voffB); PG8_STAGE(PG8_SB(0, 1), cB + hstep, voffB); PG8_STAGE(PG8_SA(0, 0), cA, voffA); PG8_STAGE(PG8_SA(0, 1), cA + hstep, voffA);
        if (wr == 1) PG8_BAR;
        PG8_WAIT_V(2); PG8_BAR;
        PG8_STAGE(PG8_SB(1, 0), cB + kstep, voffB); PG8_STAGE(PG8_SA(1, 0), cA + kstep, voffA); PG8_STAGE(PG8_SB(1, 1), cB + hstep + kstep, voffB);
        PG8_WAIT_V(6); PG8_BAR;
    } else {
        PG8_STAGE(PG8_SB(0, 0), cB, voffB); PG8_STAGE(PG8_SA(0, 0), cA, voffA); PG8_STAGE(PG8_SB(0, 1), cB + hstep, voffB); PG8_STAGE(PG8_SA(0, 1), cA + hstep, voffA);
        if (wr == 1) PG8_BAR;
        PG8_WAIT_V(4); PG8_BAR;
        PG8_STAGE(PG8_SB(1, 0), cB + kstep, voffB); PG8_STAGE(PG8_SA(1, 0), cA + kstep, voffA); PG8_STAGE(PG8_SB(1, 1), cB + hstep + kstep, voffB);
        PG8_WAIT_V(6); PG8_BAR;
    }
    for (;;) {
        const bool has_next = S.next(ui + 1, nxt);
        const char* nA = has_next ? (const char*)g.A + (size_t)nxt.pm * tstep : cA; const char* nB = has_next ? (const char*)g.Bt + (size_t)nxt.pn * tstep : cB;
        for (int t = 0; t < nt; t += 2) {
            const bool last = (t == nt - 2);
            const char* a1 = cA + (size_t)(t + 1) * kstep;
            const char* a2 = last ? nA : cA + (size_t)(t + 2) * kstep; const char* b2 = last ? nB : cB + (size_t)(t + 2) * kstep;
            const char* a3 = a2 + kstep; const char* b3 = b2 + kstep;
            if (last && has_next) S.a_ready(nxt);
            if constexpr (SP2) {
            PG8_LDB(B0, 0, 0); PG8_LDB(B1, 0, 1); PG8_SCHED; PG8_LDA(At, 0, 0); PG8_STAGE(PG8_SA(1, 1), a1 + hstep, voffA);
            PG8_WAIT_V(8); PG8_WAIT_L(0); PG8_BAR; PG8_MMA(0, 0, At, B0); PG8_MMA(0, 1, At, B1); PG8_BAR; PG8_SCHED;
            PG8_LDA(At, 0, 1); PG8_STAGE(PG8_SB(0, 0), b2, voffB); PG8_STAGE(PG8_SB(0, 1), b2 + hstep, voffB); PG8_STAGE(PG8_SA(0, 0), a2, voffA);
            PG8_WAIT_V(8); PG8_WAIT_L(0); PG8_BAR; PG8_MMA(1, 0, At, B0); PG8_MMA(1, 1, At, B1); PG8_BAR; PG8_SCHED;
            PG8_LDB(B0, 1, 0); PG8_LDB(B1, 1, 1); PG8_SCHED; PG8_LDA(At, 1, 0); PG8_STAGE(PG8_SA(0, 1), a2 + hstep, voffA);
            PG8_WAIT_V(8); PG8_WAIT_L(0); PG8_BAR; PG8_MMA(0, 0, At, B0); PG8_MMA(0, 1, At, B1); PG8_BAR; PG8_SCHED;
            PG8_LDA(At, 1, 1); PG8_STAGE(PG8_SB(1, 0), b3, voffB); PG8_STAGE(PG8_SB(1, 1), b3 + hstep, voffB); PG8_STAGE(PG8_SA(1, 0), a3, voffA);
            PG8_WAIT_V(8); PG8_WAIT_L(0); PG8_BAR; PG8_MMA(1, 0, At, B0); PG8_MMA(1, 1, At, B1); PG8_BAR; PG8_SCHED;
            } else {
            PG8_LDB(B0, 0, 0); PG8_SCHED; PG8_LDA(At, 0, 0); PG8_STAGE(PG8_SA(1, 1), a1 + hstep, voffA);
            PG8_WAIT_L(8); PG8_BAR; PG8_WAIT_L(0); PG8_MMA(0, 0, At, B0); PG8_BAR; PG8_SCHED;
            PG8_LDB(B1, 0, 1); PG8_STAGE(PG8_SB(0, 0), b2, voffB);
            PG8_BAR; PG8_WAIT_L(0); PG8_MMA(0, 1, At, B1); PG8_BAR;
            PG8_LDA(At, 0, 1); PG8_STAGE(PG8_SA(0, 0), a2, voffA);
            PG8_BAR; PG8_WAIT_L(0); PG8_MMA(1, 0, At, B0); PG8_BAR; PG8_SCHED;
            PG8_STAGE(PG8_SB(0, 1), b2 + hstep, voffB);
            PG8_WAIT_V(6); PG8_BAR; PG8_MMA(1, 1, At, B1); PG8_BAR;
            PG8_LDB(B0, 1, 0); PG8_SCHED; PG8_LDA(At, 1, 0); PG8_STAGE(PG8_SA(0, 1), a2 + hstep, voffA);
            PG8_WAIT_L(8); PG8_BAR; PG8_WAIT_L(0); PG8_MMA(0, 0, At, B0); PG8_BAR; PG8_SCHED;
            PG8_LDB(B1, 1, 1); PG8_STAGE(PG8_SB(1, 0), b3, voffB);
            PG8_BAR; PG8_WAIT_L(0); PG8_MMA(0, 1, At, B1); PG8_BAR;
            PG8_LDA(At, 1, 1); PG8_STAGE(PG8_SA(1, 0), a3, voffA);
            PG8_BAR; PG8_WAIT_L(0); PG8_MMA(1, 0, At, B0); PG8_BAR; PG8_SCHED;
            PG8_STAGE(PG8_SB(1, 1), b3 + hstep, voffB);
            PG8_WAIT_V(6); PG8_BAR; PG8_MMA(1, 1, At, B1); PG8_BAR;
            }
        }
        if constexpr (ALIGN_EPI) { if (wr == 0) PG8_BAR; }
        if constexpr (!Epi::AFTER_DRAIN) { E(acc, cur, wr, wc, fr, fq); S.done(cur); }
        if (!has_next) break;
#pragma unroll
        for (int a = 0; a < 2; ++a)
#pragma unroll
            for (int b = 0; b < 2; ++b)
#pragma unroll
                for (int m = 0; m < 4; ++m)
#pragma unroll
                    for (int n = 0; n < 2; ++n) acc[a][b][m][n] = (f32x4){0.f, 0.f, 0.f, 0.f};
        cur = nxt; cA = nA; cB = nB; ++ui;
        if constexpr (ALIGN_EPI) { if (wr == 1) PG8_BAR; }
    }
    PG8_WAIT_V(0);
    if constexpr (!ALIGN_EPI) { if (wr == 0) PG8_BAR; }
    PG8_BAR;
    if constexpr (Epi::AFTER_DRAIN) { E.fused(acc, cur, wr, wc, fr, fq, lds, wid, lane); S.done(cur); }
#undef PG8_SA
#undef PG8_SB
#undef PG8_STAGE
#undef PG8_LDA
#undef PG8_LDB
#undef PG8_MMA
#undef PG8_WAIT_V
#undef PG8_WAIT_L
#undef PG8_BAR
#undef PG8_SCHED
}
}
#ifndef PG8_SP2
#define PG8_SP2 true
#endif
#ifndef PG8_ALIGN
#define PG8_ALIGN true
#endif
#define GAS __attribute__((address_space(1)))
#define LAS __attribute__((address_space(3)))
typedef unsigned short bf16;
typedef unsigned v4u __attribute__((ext_vector_type(4)));
typedef unsigned v2u __attribute__((ext_vector_type(2)));
typedef float f32x4 __attribute__((ext_vector_type(4)));
typedef float f32x2 __attribute__((ext_vector_type(2)));
typedef GAS unsigned gu32;
#define RLX_AGENT __ATOMIC_RELAXED, __HIP_MEMORY_SCOPE_AGENT
#define LDS_WAIT() asm volatile("s_waitcnt lgkmcnt(0)" ::: "memory")
#define VM_WAIT() asm volatile("s_waitcnt vmcnt(0)" ::: "memory")
__device__ __forceinline__ unsigned f2bf(float f) { unsigned u = __builtin_bit_cast(unsigned, f); return (u + 0x7fffu + ((u >> 16) & 1u)) >> 16; }
__device__ __forceinline__ unsigned pk2(float lo, float hi) { return f2bf(lo) | (f2bf(hi) << 16); }
__device__ __forceinline__ float bf2f(unsigned short b) { return __builtin_bit_cast(float, ((unsigned)b) << 16); }
__device__ __forceinline__ float bflo(unsigned w) { return __builtin_bit_cast(float, w << 16); }
__device__ __forceinline__ float bfhi(unsigned w) { return __builtin_bit_cast(float, w & 0xffff0000u); }
__device__ __forceinline__ float fsigmoid(float x) { return __builtin_amdgcn_rcpf(1.f + __expf(-x)); }
__device__ __forceinline__ float fsilu(float x) { return x * fsigmoid(x); }
__device__ __forceinline__ float wave_sum(float v) {
#pragma unroll
    for (int o = 1; o < 64; o <<= 1) v += __shfl_xor(v, o);
    return v;
}
#define XB_TMO      128
#define XB_XCNT(j)  (256  + 64 * (j))
#define XB_XSUB(j)  (1280 + 64 * (j))
#define XB_XGEN(j)  (2304 + 64 * (j))
#define XB_TOP      3328
#define XB_TOPGEN   3392
#define XCD_BAR_WORDS 3456
#define XB_SPIN_CAP (1u << 18)

__device__ __forceinline__ unsigned xb_ld(unsigned* p)              { return __hip_atomic_load(p, __ATOMIC_RELAXED, __HIP_MEMORY_SCOPE_AGENT); }
__device__ __forceinline__ unsigned xb_add(unsigned* p, unsigned v) { return __hip_atomic_fetch_add(p, v, __ATOMIC_RELAXED, __HIP_MEMORY_SCOPE_AGENT); }
__device__ __forceinline__ unsigned xb_xcc_id() { return (unsigned)__builtin_amdgcn_s_getreg((3 << 11) | 20) & 0xFu; }
#define XB_SPIN(cond, bar) do { unsigned _sp = 0; while (cond) { __builtin_amdgcn_s_sleep(1); \
    if ((++_sp & 255u) == 0u) { if (xb_ld(&(bar)[XB_TMO])) break; if (_sp > XB_SPIN_CAP) { atomicAdd(&(bar)[XB_TMO], 1u); break; } } } } while (0)

struct XcdBarrier {
    unsigned* bar; unsigned x;
    volatile LAS unsigned* st;
};

__device__ __forceinline__ XcdBarrier xcd_barrier_post(unsigned* bar, volatile LAS unsigned* st) {
    XcdBarrier b; b.bar = bar; b.x = xb_xcc_id(); b.st = st;
    if (threadIdx.x == 0) (void)xb_add(&bar[XB_XCNT(b.x)], 1u);
    return b;
}
__device__ __forceinline__ void xcd_barrier_complete(unsigned* bar, unsigned x, unsigned& nloc, unsigned& nx) {
    const unsigned G = gridDim.x * gridDim.y * gridDim.z;
    unsigned sum, cnt, mine, sp = 0u;
    for (;;) {
        sum = 0u; cnt = 0u; mine = 0u;
#pragma unroll
        for (unsigned j = 0; j < 16; ++j) { const unsigned c = xb_ld(&bar[XB_XCNT(j)]); sum += c; cnt += (c > 0u) ? 1u : 0u; mine = (j == x) ? c : mine; }
        if (sum == G) break;
        __builtin_amdgcn_s_sleep(1);
        if ((++sp & 255u) == 0u) { if (xb_ld(&bar[XB_TMO])) break; if (sp > XB_SPIN_CAP) { atomicAdd(&bar[XB_TMO], 1u); break; } }
    }
    nloc = mine > 0u ? mine : 1u; nx = cnt > 0u ? cnt : 1u;
}

__device__ __forceinline__ void xcd_barrier(const XcdBarrier& b) {
    asm volatile("s_waitcnt vmcnt(0)" ::: "memory");
    __syncthreads();
    if (threadIdx.x == 0) {
        unsigned* bar = b.bar;
        __builtin_amdgcn_s_waitcnt(0);
        unsigned nloc = b.st[0], nx = b.st[1];
        if (nloc == 0u) { xcd_barrier_complete(bar, b.x, nloc, nx); b.st[0] = nloc; b.st[1] = nx; }
        const unsigned old = xb_add(&bar[XB_XSUB(b.x)], 1u);
        const unsigned gen = old / nloc;
        if (old + 1u == (gen + 1u) * nloc) {
            __builtin_amdgcn_fence(__ATOMIC_RELEASE, "agent");
            asm volatile("s_waitcnt vmcnt(0)" ::: "memory");
            const unsigned og = xb_add(&bar[XB_TOP], 1u);
            const unsigned tg = og / nx;
            if (og + 1u == (tg + 1u) * nx) xb_add(&bar[XB_TOPGEN], 1u);
            else XB_SPIN(xb_ld(&bar[XB_TOPGEN]) == tg, bar);
            __builtin_amdgcn_fence(__ATOMIC_ACQUIRE, "agent");
            xb_add(&bar[XB_XGEN(b.x)], 1u);
            asm volatile("s_waitcnt vmcnt(0)" ::: "memory");
        } else {
            XB_SPIN(xb_ld(&bar[XB_XGEN(b.x)]) == gen, bar);
            __builtin_amdgcn_fence(__ATOMIC_ACQUIRE, "agent");
            asm volatile("s_waitcnt vmcnt(0)" ::: "memory");
        }
    }
    __syncthreads();
}
constexpr int NWAVES = 8;
constexpr int D = 1024, SEQ = 2048, M = 16384, NIN = 11776, DFF = 2816, NEXP = 8, DEXP = 3584;
constexpr int MOE_ROWS = 136 * 256;
constexpr float DN_ALPHA = 1.41421356237309515f;
constexpr float LN_EPS = 1e-5f, RMS_EPS = 1e-6f;
constexpr size_t MiB = 1u << 20;
constexpr size_t WS_CTL = 0, CTL_ZERO_BYTES = 1 * MiB;
constexpr size_t WS_ROPE = 1 * MiB;
constexpr size_t WS_LB = 2 * MiB;
constexpr size_t WS_TOKI = WS_LB + 65536;
constexpr size_t WS_TOKW = WS_TOKI + (size_t)M * 16;
constexpr size_t WS_RSLOT = WS_TOKW + (size_t)M * 8;
constexpr size_t WS_RW = WS_RSLOT + (size_t)MOE_ROWS * 4;
static_assert(WS_RW + (size_t)MOE_ROWS * 4 <= 4 * MiB, "misc tables");
constexpr size_t WS_WIN = 4 * MiB;
constexpr size_t WS_WOUT = 50 * MiB;
constexpr size_t WS_WGU = 66 * MiB;
constexpr size_t WS_WDN = 77 * MiB;
constexpr size_t WS_HBF = 84 * MiB;
constexpr size_t WS_RQ = 116 * MiB, WS_RK = 132 * MiB, WS_RV = 148 * MiB;
constexpr size_t WS_MACC = 116 * MiB;
constexpr size_t WS_OABC = 180 * MiB;
constexpr size_t WS_GATES = 276 * MiB;
constexpr size_t WS_HQ = 372 * MiB, WS_HF = 404 * MiB, WS_HI = 436 * MiB;
constexpr size_t WS_SK = 468 * MiB, WS_SV = 476 * MiB;
constexpr size_t WS_MERGED = 484 * MiB;
constexpr size_t WS_HID = 180 * MiB;
constexpr size_t WS_WGUE = 116 * MiB;
constexpr size_t WS_WDNE = 228 * MiB;
constexpr size_t WS_HIDE = 284 * MiB;
constexpr size_t WS_XS = 4 * MiB;
constexpr size_t WS_YS = 116 * MiB;
constexpr size_t WS_HD = 520 * MiB;
constexpr size_t WS_END = WS_HIDE + (size_t)MOE_ROWS * DEXP * 2;
static_assert(WS_END <= 557 * MiB, "workspace");
static_assert(WS_XS + (size_t)MOE_ROWS * D * 2 <= WS_HBF, "XS");
constexpr int CW_TMO = 0, CW_BAR = 4096, CW_ECNT = 8192;

constexpr int RING_OFF = 0, RING_BYTES = 131072;
constexpr int LDSCTL_OFF = RING_BYTES, MISC_OFF = LDSCTL_OFF + 320;
constexpr int LDS_BYTES = 147456;

using pg8::Unit;
__device__ __forceinline__ v4u pack8(const f32x4& a, const f32x4& b) {
    v4u w; w.x = pg8::cvt_pk_bf16(a[0], a[1]); w.y = pg8::cvt_pk_bf16(a[2], a[3]); w.z = pg8::cvt_pk_bf16(b[0], b[1]); w.w = pg8::cvt_pk_bf16(b[2], b[3]); return w;
}
struct EpiProj {
    static constexpr bool PERM = true, AFTER_DRAIN = false;
    unsigned char* ws; const f32x4* rope; const float* lb;
    __device__ __forceinline__ void operator()(const f32x4 (&acc)[2][2][4][2], const Unit& u, int wr, int wc, int fr, int fq) const {
        const int pn = u.pn; const int row0 = u.pm * 256 + wr * 64 + fr;
#if MIX_HGRN_MFMA
        if (pn >= 12 && pn < 20) {
            const int hd = pn - 12, dk0 = wc * 32 + 8 * fq;
            bf16* HQ = (bf16*)(ws + WS_HQ); bf16* HF = (bf16*)(ws + WS_HF); float* DD = (float*)(ws + WS_HD);
            f32x4 lbv[2];
#pragma unroll
            for (int n = 0; n < 2; ++n) lbv[n] = lb ? *(const f32x4*)(lb + hd * 128 + dk0 + 4 * n) : (f32x4){0.f, 0.f, 0.f, 0.f};
#pragma unroll
            for (int ai = 0; ai < 2; ++ai)
#pragma unroll
                for (int m = 0; m < 4; ++m) {
                    const int row = row0 + ai * 128 + m * 16; f32x4 qt[2], kt[2], dd[2];
#pragma unroll
                    for (int n = 0; n < 2; ++n)
#pragma unroll
                        for (int j = 0; j < 4; ++j) {
                            const float q = acc[ai][0][m][n][j], z = acc[ai][1][m][n][j], l = lbv[n][j];
                            const float f = l + (1.f - l) * fsigmoid(z);
                            float bs = __logf(f);
                            bs += __builtin_bit_cast(float, __builtin_amdgcn_update_dpp(0, __builtin_bit_cast(int, bs), 0x111, 0xf, 0xf, true));
                            bs += __builtin_bit_cast(float, __builtin_amdgcn_update_dpp(0, __builtin_bit_cast(int, bs), 0x112, 0xf, 0xf, true));
                            bs += __builtin_bit_cast(float, __builtin_amdgcn_update_dpp(0, __builtin_bit_cast(int, bs), 0x114, 0xf, 0xf, true));
                            bs += __builtin_bit_cast(float, __builtin_amdgcn_update_dpp(0, __builtin_bit_cast(int, bs), 0x118, 0xf, 0xf, true));
                            const float eb = __expf(bs);
                            qt[n][j] = q * eb; kt[n][j] = (1.f - f) * __expf(-bs); dd[n][j] = eb;
                        }
                    const size_t o = (size_t)row * 1024 + hd * 128 + dk0;
                    *(v4u*)(HQ + o) = pack8(qt[0], qt[1]); *(v4u*)(HF + o) = pack8(kt[0], kt[1]);
                    if (fr == 15) { float* dp = DD + (size_t)(row >> 4) * 1024 + hd * 128 + dk0; *(f32x4*)dp = dd[0]; *(f32x4*)(dp + 4) = dd[1]; }
                }
            return;
        }
#endif
        if (pn < 4) {
            bf16* dst = (bf16*)(ws + (pn < 2 ? WS_RQ : WS_RK)); const float sc0 = pn < 2 ? 1.f : 0.08838834764831845f;
            const float nlg = pn < 2 ? 0.f : -log2f(1.f - exp2f(-5.f - (float)(2 * (pn & 1) + (wc >> 1))));
            const int dd0 = (wc & 1) * 32 + 8 * fq, colb = (2 * (pn & 1) + (wc >> 1)) * 128 + dd0;
#pragma unroll
            for (int ai = 0; ai < 2; ++ai)
#pragma unroll
                for (int m = 0; m < 4; ++m) {
                    const int row = row0 + ai * 128 + m * 16, t = row & (SEQ - 1);
                    const float sc = sc0 * exp2f((float)(row & 63) * nlg);
                    const f32x4* rp = rope + ((size_t)t * 64 + dd0) / 2;
                    f32x4 o1[2], o2[2];
#pragma unroll
                    for (int n = 0; n < 2; ++n) {
                        const f32x4 ra = rp[2 * n], rb = rp[2 * n + 1];
                        const f32x4 c = (f32x4){ra[0], ra[2], rb[0], rb[2]}, s = (f32x4){ra[1], ra[3], rb[1], rb[3]};
                        const f32x4 x1 = acc[ai][0][m][n], x2 = acc[ai][1][m][n];
                        o1[n] = (x1 * c - x2 * s) * sc; o2[n] = (x1 * s + x2 * c) * sc;
                    }
                    bf16* rowp = dst + (size_t)row * 512 + colb;
                    *(v4u*)rowp = pack8(o1[0], o1[1]); *(v4u*)(rowp + 64) = pack8(o2[0], o2[1]);
                }
            return;
        }
        size_t off; int ldc = 1024, c0, mode = 0;
        if (pn < 8) { off = WS_RV; c0 = pn - 4; }
        else if (pn < 12) { off = WS_OABC; c0 = pn - 8; mode = 1; }
        else if (pn < 16) { off = WS_HQ; c0 = pn - 12; }
        else if (pn < 20) { off = WS_HF; c0 = pn - 16; }
        else if (pn < 24) { off = WS_HI; c0 = pn - 20; }
        else if (pn < 28) { off = WS_OABC + (size_t)M * D * 2; c0 = pn - 24; mode = 1; }
        else if (pn < 32) { off = WS_OABC + (size_t)M * D * 4; c0 = pn - 28; mode = 3; }
        else if (pn < 33) { off = WS_SK; c0 = 0; ldc = 256; }
        else if (pn < 34) { off = WS_SV; c0 = 0; ldc = 256; }
        else { const int g = (pn - 34) >> 2; off = WS_GATES + (size_t)g * M * D * 2; c0 = (pn - 34) & 3; mode = 2; }
        bf16* dst = (bf16*)(ws + off) + c0 * 256 + wc * 32 + 8 * fq;
#pragma unroll
        for (int ai = 0; ai < 2; ++ai)
#pragma unroll
            for (int m = 0; m < 4; ++m) {
                bf16* rowp = dst + (size_t)(row0 + ai * 128 + m * 16) * ldc;
#pragma unroll
                for (int bj = 0; bj < 2; ++bj) {
                    f32x4 v0 = acc[ai][bj][m][0], v1 = acc[ai][bj][m][1];
                    if (mode == 1) {
#pragma unroll
                        for (int j = 0; j < 4; ++j) { v0[j] = fsilu(v0[j]); v1[j] = fsilu(v1[j]); }
                    } else if (mode == 2) {
#pragma unroll
                        for (int j = 0; j < 4; ++j) { v0[j] = fsigmoid(v0[j]); v1[j] = fsigmoid(v1[j]); }
                    } else if (mode == 3) { v0 = v0 * 0.125f; v1 = v1 * 0.125f; }
                    *(v4u*)(rowp + bj * 128) = pack8(v0, v1);
                }
            }
    }
};
struct EpiMerge {
    static constexpr bool PERM = true, AFTER_DRAIN = false;
    const bf16* gates; float* macc; bf16* merged;
    __device__ __forceinline__ void operator()(const f32x4 (&acc)[2][2][4][2], const Unit& u, int wr, int wc, int fr, int fq) const {
        const int which = u.pn >> 2, pn = u.pn & 3, pm = u.pm & 63;
        const int row0 = pm * 256 + wr * 64 + fr, col0 = pn * 256 + wc * 32 + 8 * fq;
        const bf16* gp = gates + (size_t)which * M * D;
#pragma unroll
        for (int ai = 0; ai < 2; ++ai)
#pragma unroll
            for (int m = 0; m < 4; ++m) {
                const size_t ro = (size_t)(row0 + ai * 128 + m * 16) * D + col0;
#pragma unroll
                for (int bj = 0; bj < 2; ++bj) {
                    const size_t o = ro + bj * 128;
                    const v4u g = *(const v4u*)(gp + o);
                    f32x4 v0 = acc[ai][bj][m][0] * (f32x4){bflo(g.x), bfhi(g.x), bflo(g.y), bfhi(g.y)};
                    f32x4 v1 = acc[ai][bj][m][1] * (f32x4){bflo(g.z), bfhi(g.z), bflo(g.w), bfhi(g.w)};
                    float* mp = macc + o;
                    if (which != 0) { v0 += *(const f32x4*)mp; v1 += *(const f32x4*)(mp + 4); }
                    if (which != 2) { *(f32x4*)mp = v0; *(f32x4*)(mp + 4) = v1; }
                    else *(v4u*)(merged + o) = pack8(v0, v1);
                }
            }
    }
};
struct EpiResid {
    static constexpr bool PERM = true, AFTER_DRAIN = false;
    float* P;
    __device__ __forceinline__ void operator()(const f32x4 (&acc)[2][2][4][2], const Unit& u, int wr, int wc, int fr, int fq) const {
        const int row0 = u.pm * 256 + wr * 64 + fr, col0 = u.pn * 256 + wc * 32 + 8 * fq;
#pragma unroll
        for (int ai = 0; ai < 2; ++ai)
#pragma unroll
            for (int m = 0; m < 4; ++m) {
                float* rp = P + (size_t)(row0 + ai * 128 + m * 16) * D + col0;
#pragma unroll
                for (int bj = 0; bj < 2; ++bj) {
                    float* p = rp + bj * 128;
                    const f32x4 a = *(const f32x4*)p, b = *(const f32x4*)(p + 4);
                    *(f32x4*)p = a * DN_ALPHA + acc[ai][bj][m][0]; *(f32x4*)(p + 4) = b * DN_ALPHA + acc[ai][bj][m][1];
                }
            }
    }
};
struct EpiSwiglu {
    static constexpr bool PERM = true, AFTER_DRAIN = false;
    bf16* H; int ldh, nN;
    __device__ __forceinline__ void operator()(const f32x4 (&acc)[2][2][4][2], const Unit& u, int wr, int wc, int fr, int fq) const {
        const int n = u.pn % nN; const int row0 = u.pm * 256 + wr * 64 + fr, col0 = n * 128 + wc * 32 + 8 * fq;
#pragma unroll
        for (int ai = 0; ai < 2; ++ai)
#pragma unroll
            for (int m = 0; m < 4; ++m) {
                f32x4 v0 = acc[ai][0][m][0], v1 = acc[ai][0][m][1];
#pragma unroll
                for (int j = 0; j < 4; ++j) { v0[j] = fsilu(v0[j]); v1[j] = fsilu(v1[j]); }
                v0 = v0 * acc[ai][1][m][0]; v1 = v1 * acc[ai][1][m][1];
                *(v4u*)(H + (size_t)(row0 + ai * 128 + m * 16) * ldh + col0) = pack8(v0, v1);
            }
    }
};
struct EpiMoeDown {
    static constexpr bool PERM = true, AFTER_DRAIN = false;
    bf16* YS; const int* rowslot; const float* roww;
    __device__ __forceinline__ void operator()(const f32x4 (&acc)[2][2][4][2], const Unit& u, int wr, int wc, int fr, int fq) const {
        const int n = u.pn & 3; const int row0 = u.pm * 256 + wr * 64 + fr, col0 = n * 256 + wc * 32 + 8 * fq;
#pragma unroll
        for (int ai = 0; ai < 2; ++ai)
#pragma unroll
            for (int m = 0; m < 4; ++m) {
                const int r = row0 + ai * 128 + m * 16; const int slot = rowslot[r]; const float w = roww[r];
                if (slot >= 0) {
                    bf16* rp = YS + (size_t)slot * D + col0;
#pragma unroll
                    for (int bj = 0; bj < 2; ++bj) *(v4u*)(rp + bj * 128) = pack8(acc[ai][bj][m][0] * w, acc[ai][bj][m][1] * w);
                }
            }
    }
};
struct MergeOrder {
    pg8::StaticOrder S;
    __device__ bool next(int i, Unit& u) const { const int rnd = i / 3, which = i - 3 * rnd; if (!S.next(rnd, u)) return false; u.pm += which * 64; u.pn += which * 4; return true; }
    __device__ __forceinline__ void a_ready(const Unit&) const {}
    __device__ __forceinline__ void done(const Unit&) const {}
};
struct MoeOrder {
    pg8::StaticOrder S; int pend[NEXP]; int nN;
    __device__ void init(const unsigned* cnt, int nN_, int G, int c) {
        int p = 0;
#pragma unroll
        for (int e = 0; e < NEXP; ++e) { p += ((int)cnt[64 * e] + 255) >> 8; pend[e] = p; }
        nN = nN_; S.init(p * 256, nN_ * 256, G, c);
    }
    __device__ bool next(int i, Unit& u) const {
        if (!S.next(i, u)) return false;
        int e = 0;
#pragma unroll
        for (int k = 0; k < NEXP - 1; ++k) e += (u.pm >= pend[k]) ? 1 : 0;
        u.pn += e * nN; return true;
    }
    __device__ __forceinline__ void a_ready(const Unit&) const {}
    __device__ __forceinline__ void done(const Unit&) const {}
};
__device__ __forceinline__ void transpose_item(const float* W, int ldn, int k0, int n0, bf16* WT, int K, int drow0, LAS float* scr, int lane) {
#pragma unroll 8
    for (int i = 0; i < 32; ++i) { const int kk = 2 * i + (lane >> 5); scr[kk * 33 + (lane & 31)] = W[(size_t)(k0 + kk) * ldn + n0 + (lane & 31)]; }
    LDS_WAIT(); asm volatile("" ::: "memory");
    const int c = lane & 7;
#pragma unroll
    for (int j = 0; j < 4; ++j) { const int n = (lane >> 3) + 8 * j; const LAS float* s = scr + (8 * c) * 33 + n;
        v4u o; o.x = pk2(s[0 * 33], s[1 * 33]); o.y = pk2(s[2 * 33], s[3 * 33]); o.z = pk2(s[4 * 33], s[5 * 33]); o.w = pk2(s[6 * 33], s[7 * 33]);
        *(GAS v4u*)(WT + (size_t)(drow0 + n) * K + k0 + 8 * c) = o; }
    LDS_WAIT(); asm volatile("" ::: "memory");
}
__device__ __forceinline__ int win_row(int s) {
#if MIX_HGRN_MFMA
    if (s >= 3072 && s < 5120) { const int z = s >= 4096, hd = ((s - 3072) & 1023) >> 7; return (12 + hd) * 256 + z * 128 + (s & 127); }
#endif
    if (s >= 1024) return s;
    const int which = s >> 9, head = (s & 511) >> 7, d = s & 127, bj = d >> 6, dd = d & 63;
    return (which * 2 + (head >> 1)) * 256 + bj * 128 + (head & 1) * 64 + dd;
}
__device__ __forceinline__ int gu_row(int s, int up) { return 256 * (s >> 7) + (s & 127) + (up ? 128 : 0); }

__device__ __forceinline__ const float* INP(int i) {
    const float* const* p = (const float* const*)__builtin_amdgcn_kernarg_segment_ptr();
    asm volatile("" : "+s"(p));
    return p[i];
}
__device__ __forceinline__ unsigned char* WSP() {
    unsigned char* const* p = (unsigned char* const*)__builtin_amdgcn_kernarg_segment_ptr();
    asm volatile("" : "+s"(p));
    return p[23];
}
struct Args { const float* in[22]; float* out; unsigned char* ws; int ph_lo, ph_hi; };
typedef Args Ptrs;

__device__ __forceinline__ void prologue_convert(LAS float* scr, int gw, int NGW, int lane) {
    constexpr int I_WIN = (D / 64) * (NIN / 32);
    constexpr int I_SQ = (D / 64) * (D / 32);
    constexpr int I_F = (D / 64) * (DFF / 32);
    constexpr int NITEMS = 2 * I_WIN + 8 * I_SQ + 3 * I_F;
    unsigned char* ws = WSP();
    for (int it = gw; it < NITEMS; it += NGW) {
        int r = it;
        if (r < 2 * I_WIN) { const int l = r / I_WIN; r -= l * I_WIN; const int nblk = NIN / 32, kb = r / nblk, nb = r % nblk;
            transpose_item(INP(3) + (size_t)l * D * NIN, NIN, 64 * kb, 32 * nb, (bf16*)(ws + WS_WIN) + (size_t)l * NIN * D, D, win_row(32 * nb), scr, lane); continue; }
        r -= 2 * I_WIN;
        if (r < 8 * I_SQ) { const int mi = r / I_SQ; r -= mi * I_SQ; const int l = mi >> 2, w = mi & 3;
            const float* src = (w == 0 ? INP(4) : w == 1 ? INP(7) : w == 2 ? INP(9) : INP(10)) + (size_t)l * D * D;
            bf16* dst = (bf16*)(ws + WS_WOUT + (size_t)l * 8 * MiB) + (size_t)w * D * D;
            const int kb = r / 32, nb = r % 32; transpose_item(src, D, 64 * kb, 32 * nb, dst, D, 32 * nb, scr, lane); continue; }
        r -= 8 * I_SQ;
        if (r < 2 * I_F) { const int up = r / I_F; r -= up * I_F; const int nblk = DFF / 32, kb = r / nblk, nb = r % nblk;
            transpose_item(up ? INP(14) : INP(13), DFF, 64 * kb, 32 * nb, (bf16*)(ws + WS_WGU), D, gu_row(32 * nb, up), scr, lane); continue; }
        r -= 2 * I_F;
        { const int kb = r / 32, nb = r % 32; transpose_item(INP(15), D, 64 * kb, 32 * nb, (bf16*)(ws + WS_WDN), DFF, 32 * nb, scr, lane); }
    }
}
__device__ __forceinline__ void moe_convert(LAS float* scr, int gw, int NGW, int lane) {
    constexpr int I_E = (D / 64) * (DEXP / 32);
    unsigned char* ws = WSP();
    for (int it = gw; it < 24 * I_E; it += NGW) {
        const int mi = it / I_E, r = it - mi * I_E, kind = mi >> 3, e = mi & 7;
        if (kind < 2) { const int nblk = DEXP / 32, kb = r / nblk, nb = r % nblk;
            transpose_item((kind ? INP(18) : INP(17)) + (size_t)e * D * DEXP, DEXP, 64 * kb, 32 * nb, (bf16*)(ws + WS_WGUE) + (size_t)e * 2 * DEXP * D, D, gu_row(32 * nb, kind), scr, lane); }
        else { const int kb = r / 32, nb = r % 32;
            transpose_item(INP(19) + (size_t)e * DEXP * D, D, 64 * kb, 32 * nb, (bf16*)(ws + WS_WDNE) + (size_t)e * D * DEXP, DEXP, 32 * nb, scr, lane); }
    }
}
__device__ __forceinline__ void ln_core(f32x4 (&v)[4], const float* g, const float* b, int lane) {
    float s = 0.f;
#pragma unroll
    for (int j = 0; j < 4; ++j) s += (v[j][0] + v[j][1]) + (v[j][2] + v[j][3]);
    const float mean = wave_sum(s) * (1.f / D); float s2 = 0.f;
#pragma unroll
    for (int j = 0; j < 4; ++j) { v[j] = v[j] - mean; s2 += (v[j][0] * v[j][0] + v[j][1] * v[j][1]) + (v[j][2] * v[j][2] + v[j][3] * v[j][3]); }
    const float rstd = 1.f / sqrtf(wave_sum(s2) * (1.f / D) + LN_EPS);
#pragma unroll
    for (int j = 0; j < 4; ++j) { const f32x4 gg = *(const f32x4*)(g + 4 * lane + 256 * j), bb = *(const f32x4*)(b + 4 * lane + 256 * j); v[j] = v[j] * rstd * gg + bb; }
}
__device__ __forceinline__ void store_row_f32(float* dst, const f32x4 (&v)[4], int lane) {
#pragma unroll
    for (int j = 0; j < 4; ++j) *(f32x4*)(dst + 4 * lane + 256 * j) = v[j];
}
__device__ __forceinline__ void store_row_bf16(bf16* dst, const f32x4 (&v)[4], int lane) {
#pragma unroll
    for (int j = 0; j < 4; ++j) { v2u w; w.x = pk2(v[j][0], v[j][1]); w.y = pk2(v[j][2], v[j][3]); *(v2u*)(dst + 4 * lane + 256 * j) = w; }
}
__device__ __forceinline__ void ret_seq(unsigned char* ws, int item, LAS float* sm, int tid) {
    const int b = item >> 2, h = item & 3, dv = tid & 255, kh = tid >> 8, wave = tid >> 6, lane = tid & 63;
    const float gamma = 1.f - exp2f(-5.f - (float)h);
    const bf16* RQ = (const bf16*)(ws + WS_RQ); const bf16* RK = (const bf16*)(ws + WS_RK); const bf16* RV = (const bf16*)(ws + WS_RV); bf16* RG = (bf16*)(ws + WS_OABC);
    LAS float* qs = sm; LAS float* ks = sm + 2048; LAS float* part = sm + 4096;
    float S[64];
#pragma unroll
    for (int i = 0; i < 64; ++i) S[i] = 0.f;
    for (int c0 = 0; c0 < SEQ; c0 += 16) {
        const size_t row0 = (size_t)b * SEQ + c0;
        for (int i = tid; i < 2048; i += 512) { const int t = i >> 7, d = i & 127; qs[i] = bf2f(RQ[(row0 + t) * 512 + h * 128 + d]); ks[i] = bf2f(RK[(row0 + t) * 512 + h * 128 + d]) * exp2f((float)((c0 + t) & 63) * log2f(gamma)); }
        __syncthreads();
        for (int t = 0; t < 16; ++t) {
            const float v = bf2f(RV[(row0 + t) * 1024 + h * 256 + dv]); float po = 0.f;
            const LAS float* kp = ks + t * 128 + kh * 64; const LAS float* qp = qs + t * 128 + kh * 64;
#pragma unroll
            for (int i = 0; i < 64; ++i) { S[i] = gamma * S[i] + kp[i] * v; po += qp[i] * S[i]; }
            part[(t * 2 + kh) * 256 + dv] = po;
        }
        __syncthreads();
#pragma unroll
        for (int tt = 0; tt < 2; ++tt) {
            const int t = 2 * wave + tt; float o[4]; float ss = 0.f;
#pragma unroll
            for (int j = 0; j < 4; ++j) { o[j] = part[(t * 2) * 256 + lane * 4 + j] + part[(t * 2 + 1) * 256 + lane * 4 + j]; ss += o[j] * o[j]; }
            const float rstd = 1.f / sqrtf(wave_sum(ss) * (1.f / 256.f) + RMS_EPS);
            bf16* gp = RG + (row0 + t) * 1024 + h * 256 + lane * 4; const v2u g = *(const v2u*)gp;
            v2u w; w.x = pk2(o[0] * rstd * bflo(g.x), o[1] * rstd * bfhi(g.x)); w.y = pk2(o[2] * rstd * bflo(g.y), o[3] * rstd * bfhi(g.y));
            *(v2u*)gp = w;
        }
        __syncthreads();
    }
}
__device__ __forceinline__ void hgrn_seq(unsigned char* ws, const float* lb, const float* ng, int item, LAS float* sm, int tid) {
    const int b = item >> 3, h = item & 7, dv = tid & 127, kq = tid >> 7, wave = tid >> 6, lane = tid & 63;
    const bf16* HQ = (const bf16*)(ws + WS_HQ); const bf16* HF = (const bf16*)(ws + WS_HF); const bf16* HI = (const bf16*)(ws + WS_HI); bf16* HG = (bf16*)(ws + WS_OABC) + (size_t)M * D;
    LAS float* fs = sm; LAS float* qs = sm + 2048; LAS float* part = sm + 4096;
    float S[32];
#pragma unroll
    for (int i = 0; i < 32; ++i) S[i] = 0.f;
    for (int c0 = 0; c0 < SEQ; c0 += 16) {
        const size_t row0 = (size_t)b * SEQ + c0;
        for (int i = tid; i < 2048; i += 512) { const int t = i >> 7, d = i & 127; const float z = bf2f(HF[(row0 + t) * 1024 + h * 128 + d]); const float l = lb ? lb[h * 128 + d] : 0.f;
            fs[i] = l + (1.f - l) * fsigmoid(z); qs[i] = bf2f(HQ[(row0 + t) * 1024 + h * 128 + d]); }
        __syncthreads();
        for (int t = 0; t < 16; ++t) {
            const float v = bf2f(HI[(row0 + t) * 1024 + h * 128 + dv]); float po = 0.f;
            const LAS float* fp = fs + t * 128 + kq * 32; const LAS float* qp = qs + t * 128 + kq * 32;
#pragma unroll
            for (int i = 0; i < 32; ++i) { const float f = fp[i]; S[i] = f * S[i] + (1.f - f) * v; po += qp[i] * S[i]; }
            part[(t * 4 + kq) * 128 + dv] = po;
        }
        __syncthreads();
#pragma unroll
        for (int tt = 0; tt < 2; ++tt) {
            const int t = 2 * wave + tt; float o[2]; float ss = 0.f;
#pragma unroll
            for (int j = 0; j < 2; ++j) { const int c = lane * 2 + j; o[j] = (part[(t * 4) * 128 + c] + part[(t * 4 + 1) * 128 + c]) + (part[(t * 4 + 2) * 128 + c] + part[(t * 4 + 3) * 128 + c]); ss += o[j] * o[j]; }
            const float rstd = 1.f / sqrtf(wave_sum(ss) * (1.f / 128.f) + RMS_EPS);
            bf16* gp = HG + (row0 + t) * 1024 + h * 128 + lane * 2; const unsigned g = *(const unsigned*)gp;
            *(unsigned*)gp = pk2(o[0] * rstd * ng[lane * 2] * bflo(g), o[1] * rstd * ng[lane * 2 + 1] * bfhi(g));
        }
        __syncthreads();
    }
}
__device__ __forceinline__ void swa_seq(unsigned char* ws, const float* sinks, int item, int lane) {
    const int hq = item & 15, c = (item >> 4) & 31, b = item >> 9, kvh = hq >> 2;
    bf16* SQ = (bf16*)(ws + WS_OABC) + (size_t)2 * M * D; const bf16* SK = (const bf16*)(ws + WS_SK); const bf16* SV = (const bf16*)(ws + WS_SV);
    bf16* qp = SQ + ((size_t)b * SEQ + c * 64 + lane) * 1024 + hq * 64;
    float q[64], o[64];
#pragma unroll
    for (int i = 0; i < 8; ++i) { const v4u w = *(const v4u*)(qp + 8 * i);
        q[8 * i] = bflo(w.x); q[8 * i + 1] = bfhi(w.x); q[8 * i + 2] = bflo(w.y); q[8 * i + 3] = bfhi(w.y); q[8 * i + 4] = bflo(w.z); q[8 * i + 5] = bfhi(w.z); q[8 * i + 6] = bflo(w.w); q[8 * i + 7] = bfhi(w.w); }
#pragma unroll
    for (int i = 0; i < 64; ++i) o[i] = 0.f;
    float mx = sinks[hq], l = 1.f;
    const int s0 = (c >= 2 ? c - 2 : 0) * 64, s1 = c * 64 + 64;
    for (int s = s0; s < s1; ++s) {
        const bf16* kp = SK + ((size_t)b * SEQ + s) * 256 + kvh * 64; const bf16* vp = SV + ((size_t)b * SEQ + s) * 256 + kvh * 64;
        float sc = 0.f;
#pragma unroll
        for (int i = 0; i < 8; ++i) { const v4u w = *(const v4u*)(kp + 8 * i);
            sc += q[8 * i] * bflo(w.x) + q[8 * i + 1] * bfhi(w.x) + q[8 * i + 2] * bflo(w.y) + q[8 * i + 3] * bfhi(w.y) + q[8 * i + 4] * bflo(w.z) + q[8 * i + 5] * bfhi(w.z) + q[8 * i + 6] * bflo(w.w) + q[8 * i + 7] * bfhi(w.w); }
        const float mn = fmaxf(mx, sc), a = __expf(mx - mn), p = __expf(sc - mn); mx = mn; l = l * a + p;
#pragma unroll
        for (int i = 0; i < 8; ++i) { const v4u w = *(const v4u*)(vp + 8 * i);
            o[8 * i] = o[8 * i] * a + p * bflo(w.x); o[8 * i + 1] = o[8 * i + 1] * a + p * bfhi(w.x); o[8 * i + 2] = o[8 * i + 2] * a + p * bflo(w.y); o[8 * i + 3] = o[8 * i + 3] * a + p * bfhi(w.y);
            o[8 * i + 4] = o[8 * i + 4] * a + p * bflo(w.z); o[8 * i + 5] = o[8 * i + 5] * a + p * bfhi(w.z); o[8 * i + 6] = o[8 * i + 6] * a + p * bflo(w.w); o[8 * i + 7] = o[8 * i + 7] * a + p * bfhi(w.w); }
    }
    const float inv = 1.f / l;
#pragma unroll
    for (int i = 0; i < 8; ++i) { v4u w; w.x = pk2(o[8 * i] * inv, o[8 * i + 1] * inv); w.y = pk2(o[8 * i + 2] * inv, o[8 * i + 3] * inv); w.z = pk2(o[8 * i + 4] * inv, o[8 * i + 5] * inv); w.w = pk2(o[8 * i + 6] * inv, o[8 * i + 7] * inv);
        *(v4u*)(qp + 8 * i) = w; }
}
typedef float f32x16 __attribute__((ext_vector_type(16)));
typedef short bf16x8 __attribute__((ext_vector_type(8)));
typedef short s16x4 __attribute__((ext_vector_type(4)));
typedef __bf16 bf16x2_t __attribute__((ext_vector_type(2)));
__device__ __forceinline__ unsigned pkbf(float a, float b) { f32x2 v = {a, b}; bf16x2_t r = __builtin_convertvector(v, bf16x2_t); return __builtin_bit_cast(unsigned, r); }
#define MFMA32(a, b, c) __builtin_amdgcn_mfma_f32_32x32x16_bf16((a), (b), (c), 0, 0, 0)
#define MFMA16(a, b, c) __builtin_amdgcn_mfma_f32_16x16x32_bf16((a), (b), (c), 0, 0, 0)
#define MFMA16K16(a, b, c) __builtin_amdgcn_mfma_f32_16x16x16bf16_1k((a), (b), (c), 0, 0, 0)
__device__ __forceinline__ s16x4 lds_tr4(LAS unsigned char* p) { return __builtin_amdgcn_ds_read_tr16_b64_v4i16((LAS s16x4*)p); }
__device__ __forceinline__ bf16x8 cat8(s16x4 a, s16x4 b) { return (bf16x8){a[0], a[1], a[2], a[3], b[0], b[1], b[2], b[3]}; }
__device__ __forceinline__ bf16x8 pack8r(const f32x16& x, int s8) {
    v4u p; p.x = pkbf(x[s8], x[s8 + 1]); p.y = pkbf(x[s8 + 2], x[s8 + 3]); p.z = pkbf(x[s8 + 4], x[s8 + 5]); p.w = pkbf(x[s8 + 6], x[s8 + 7]); return __builtin_bit_cast(bf16x8, p);
}
constexpr int SWA_KP = 144, SWA_VP = 192, SWA_VOFF = 192 * SWA_KP;
__device__ __forceinline__ void swa_unit(unsigned char* ws, const float* sinks, int unit, LAS unsigned char* sm) {
    int tid_ = threadIdx.x; asm volatile("" : "+v"(tid_));
    const int tid = tid_, lane = tid & 63, wave = __builtin_amdgcn_readfirstlane(tid >> 6), h = lane >> 5, r31 = lane & 31;
    const int kvh = unit & 3, c = (unit >> 2) & 31, b = unit >> 7;
    const int nch = c < 2 ? c + 1 : 3, nk = nch * 64, s0 = (c + 1 - nch) * 64;
    bf16* SQ = (bf16*)(ws + WS_OABC) + (size_t)2 * M * D; const bf16* SK = (const bf16*)(ws + WS_SK); const bf16* SV = (const bf16*)(ws + WS_SV);
    for (int idx = tid; idx < nk * 8; idx += 512) {
        const int row = idx >> 3, ch = idx & 7; const size_t g = ((size_t)b * SEQ + s0 + row) * 256 + kvh * 64 + ch * 8;
        const v4u kv = *(const v4u*)(SK + g), vv = *(const v4u*)(SV + g);
        *(LAS v4u*)(sm + row * SWA_KP + ch * 16) = kv; *(LAS v4u*)(sm + SWA_VOFF + row * SWA_VP + ch * 16) = vv;
    }
    const int hq = kvh * 4 + (wave >> 1);
    bf16* qp = SQ + ((size_t)b * SEQ + c * 64 + (wave & 1) * 32 + r31) * 1024 + hq * 64;
    bf16x8 bq[4];
#pragma unroll
    for (int ks = 0; ks < 4; ++ks) bq[ks] = *(const bf16x8*)(qp + 16 * ks + 8 * h);
    const float sink = sinks[hq];
    __syncthreads();
    f32x16 st[6];
#pragma unroll
    for (int kt = 0; kt < 6; ++kt) {
        if (kt < 2 * nch) {
            f32x16 a = {0.f, 0.f, 0.f, 0.f, 0.f, 0.f, 0.f, 0.f, 0.f, 0.f, 0.f, 0.f, 0.f, 0.f, 0.f, 0.f};
#pragma unroll
            for (int ks = 0; ks < 4; ++ks) { const bf16x8 kf = *(const LAS bf16x8*)(sm + (32 * kt + r31) * SWA_KP + (16 * ks + 8 * h) * 2); a = MFMA32(kf, bq[ks], a); }
            st[kt] = a;
        } else {
#pragma unroll
            for (int r = 0; r < 16; ++r) st[kt][r] = -1.0e30f;
        }
    }
    float mx = sink;
#pragma unroll
    for (int kt = 0; kt < 6; ++kt)
#pragma unroll
        for (int r = 0; r < 16; ++r) mx = fmaxf(mx, st[kt][r]);
    mx = fmaxf(mx, __shfl_xor(mx, 32));
    float l = 0.f;
#pragma unroll
    for (int kt = 0; kt < 6; ++kt)
#pragma unroll
        for (int r = 0; r < 16; ++r) { const float p = __expf(st[kt][r] - mx); st[kt][r] = p; l += p; }
    l += __shfl_xor(l, 32); l += __expf(sink - mx);
    f32x16 o[2];
#pragma unroll
    for (int dt = 0; dt < 2; ++dt)
#pragma unroll
        for (int r = 0; r < 16; ++r) o[dt][r] = 0.f;
    LAS unsigned char* vbase = sm + SWA_VOFF + (4 * h + ((lane & 15) >> 2)) * SWA_VP + (16 * ((lane >> 4) & 1) + 4 * (lane & 3)) * 2;
#pragma unroll
    for (int kt = 0; kt < 6; ++kt) {
        if (kt < 2 * nch) {
#pragma unroll
            for (int s = 0; s < 2; ++s) {
                const bf16x8 pb = pack8r(st[kt], 8 * s);
#pragma unroll
                for (int dt = 0; dt < 2; ++dt) {
                    LAS unsigned char* vp = vbase + (32 * kt + 16 * s) * SWA_VP + 64 * dt;
                    const bf16x8 vf = cat8(lds_tr4(vp), lds_tr4(vp + 8 * SWA_VP));
                    o[dt] = MFMA32(vf, pb, o[dt]);
                }
            }
        }
    }
    const float inv = 1.f / l;
#pragma unroll
    for (int dt = 0; dt < 2; ++dt)
#pragma unroll
        for (int rg = 0; rg < 4; ++rg) {
            v2u w; w.x = pkbf(o[dt][4 * rg] * inv, o[dt][4 * rg + 1] * inv); w.y = pkbf(o[dt][4 * rg + 2] * inv, o[dt][4 * rg + 3] * inv);
            *(v2u*)(qp + 32 * dt + 8 * rg + 4 * h) = w;
        }
    __syncthreads();
}
constexpr int RT_QP = 272, RT_VP = 576, RT_PP = 144;
constexpr int RT_QOFF = 0, RT_KOFF = 64 * RT_QP, RT_VOFF = 2 * 64 * RT_QP, RT_POFF = RT_VOFF + 64 * RT_VP, RT_SOFF = RT_POFF + 64 * RT_PP;
__device__ __forceinline__ void ret_unit(unsigned char* ws, int item, LAS unsigned char* sm) {
    int tid_ = threadIdx.x; asm volatile("" : "+v"(tid_));
    const int tid = tid_, lane = tid & 63, w = __builtin_amdgcn_readfirstlane(tid >> 6), h = lane >> 5, r31 = lane & 31, g4 = lane >> 4, c15 = lane & 15, blk = (lane >> 4) & 1, p3 = lane & 3;
    const int b = item >> 2, hd = item & 3;
    const float lg = log2f(1.f - exp2f(-5.f - (float)hd)), g64 = exp2f(64.f * lg);
    const bf16* RQ = (const bf16*)(ws + WS_RQ); const bf16* RK = (const bf16*)(ws + WS_RK); const bf16* RV = (const bf16*)(ws + WS_RV); bf16* RG = (bf16*)(ws + WS_OABC);
    LAS float* part = (LAS float*)(sm + RT_SOFF);
    v4u pq[2], pk[2], pv[4];
    const int qrow = tid >> 4, qch = tid & 15, vrow = tid >> 5, vch = tid & 31;
#define RT_LOAD(n_) do { const size_t r0_ = (size_t)b * SEQ + 64 * (n_); \
        _Pragma("unroll") for (int j = 0; j < 2; ++j) { pq[j] = *(const v4u*)(RQ + (r0_ + qrow + 32 * j) * 512 + hd * 128 + qch * 8); pk[j] = *(const v4u*)(RK + (r0_ + qrow + 32 * j) * 512 + hd * 128 + qch * 8); } \
        _Pragma("unroll") for (int j = 0; j < 4; ++j) pv[j] = *(const v4u*)(RV + (r0_ + vrow + 16 * j) * 1024 + hd * 256 + vch * 8); } while (0)
#define RT_STORE() do { \
        _Pragma("unroll") for (int j = 0; j < 2; ++j) { *(LAS v4u*)(sm + RT_QOFF + (qrow + 32 * j) * RT_QP + qch * 16) = pq[j]; *(LAS v4u*)(sm + RT_KOFF + (qrow + 32 * j) * RT_QP + qch * 16) = pk[j]; } \
        _Pragma("unroll") for (int j = 0; j < 4; ++j) *(LAS v4u*)(sm + RT_VOFF + (vrow + 16 * j) * RT_VP + vch * 16) = pv[j]; } while (0)
    RT_LOAD(0); RT_STORE();
    if (tid < 64) { const int tile = tid >> 5, rr = (tid >> 1) & 15, cc = tid & 1;
        *(LAS v4u*)(sm + RT_POFF + (32 * tile + rr) * RT_PP + (16 + 32 * tile + 8 * cc) * 2) = (v4u){0u, 0u, 0u, 0u}; }
    f32x16 sp[4];
#pragma unroll
    for (int i = 0; i < 4; ++i)
#pragma unroll
        for (int r = 0; r < 16; ++r) sp[i][r] = 0.f;
    __syncthreads();
    for (int n = 0; n < 32; ++n) {
        const size_t row0 = (size_t)b * SEQ + 64 * n;
        if (n + 1 < 32) RT_LOAD(n + 1);
        for (int tile = w; tile < 10; tile += 8) {
            const int tb = tile < 1 ? 0 : tile < 3 ? 1 : tile < 6 ? 2 : 3, sb = tile - (tb * (tb + 1)) / 2;
            f32x4 a = {0.f, 0.f, 0.f, 0.f};
#pragma unroll
            for (int st = 0; st < 4; ++st) {
                const bf16x8 kf = *(const LAS bf16x8*)(sm + RT_KOFF + (16 * sb + c15) * RT_QP + (32 * st + 8 * g4) * 2);
                const bf16x8 qf = *(const LAS bf16x8*)(sm + RT_QOFF + (16 * tb + c15) * RT_QP + (32 * st + 8 * g4) * 2);
                a = MFMA16(kf, qf, a);
            }
            if (tb == sb) {
#pragma unroll
                for (int r = 0; r < 4; ++r) if (4 * g4 + r > c15) a[r] = 0.f;
            }
            v2u pw; pw.x = pkbf(a[0], a[1]); pw.y = pkbf(a[2], a[3]);
            *(LAS v2u*)(sm + RT_POFF + (16 * tb + c15) * RT_PP + (16 * sb + 4 * g4) * 2) = pw;
        }
        __syncthreads();
        f32x16 oa[2];
#pragma unroll
        for (int tt = 0; tt < 2; ++tt)
#pragma unroll
            for (int r = 0; r < 16; ++r) oa[tt][r] = 0.f;
        bf16x8 vf[4];
#pragma unroll
        for (int ss = 0; ss < 4; ++ss) { LAS unsigned char* vp = sm + RT_VOFF + (16 * ss + 8 * h + (c15 >> 2)) * RT_VP + (32 * w + 16 * blk + 4 * p3) * 2; vf[ss] = cat8(lds_tr4(vp), lds_tr4(vp + 4 * RT_VP)); }
#pragma unroll
        for (int dkt = 0; dkt < 4; ++dkt)
#pragma unroll
            for (int s2 = 0; s2 < 2; ++s2) {
                const bf16x8 af = pack8r(sp[dkt], 8 * s2);
#pragma unroll
                for (int tt = 0; tt < 2; ++tt) {
                    const LAS unsigned char* qp = sm + RT_QOFF + (32 * tt + r31) * RT_QP + (32 * dkt + 16 * s2 + 4 * h) * 2;
                    const v2u q0 = *(const LAS v2u*)qp, q1 = *(const LAS v2u*)(qp + 16);
                    oa[tt] = MFMA32(af, __builtin_bit_cast(bf16x8, ((v4u){q0.x, q0.y, q1.x, q1.y})), oa[tt]);
                }
            }
#pragma unroll
        for (int tt = 0; tt < 2; ++tt)
#pragma unroll
            for (int ss = 0; ss < 4; ++ss) {
                if (ss < 2 * tt + 2) { const bf16x8 pf = *(const LAS bf16x8*)(sm + RT_POFF + (32 * tt + r31) * RT_PP + (16 * ss + 8 * h) * 2); oa[tt] = MFMA32(vf[ss], pf, oa[tt]); }
            }
#pragma unroll
        for (int dkt = 0; dkt < 4; ++dkt) {
#pragma unroll
            for (int ss = 0; ss < 4; ++ss) { LAS unsigned char* kp = sm + RT_KOFF + (16 * ss + 8 * h + (c15 >> 2)) * RT_QP + (32 * dkt + 16 * blk + 4 * p3) * 2;
                sp[dkt] = MFMA32(cat8(lds_tr4(kp), lds_tr4(kp + 4 * RT_QP)), vf[ss], sp[dkt]); }
#pragma unroll
            for (int r = 0; r < 16; ++r) sp[dkt][r] *= g64;
        }
#pragma unroll
        for (int tt = 0; tt < 2; ++tt) { float ss = 0.f;
#pragma unroll
            for (int r = 0; r < 16; ++r) ss += oa[tt][r] * oa[tt][r];
            ss += __shfl_xor(ss, 32); if (h == 0) part[(32 * tt + r31) * 8 + w] = ss; }
        __syncthreads();
#pragma unroll
        for (int tt = 0; tt < 2; ++tt) {
            const int t = 32 * tt + r31; const f32x4 pa = *(const LAS f32x4*)(part + t * 8), pb2 = *(const LAS f32x4*)(part + t * 8 + 4);
            const float tot = ((pa[0] + pa[1]) + (pa[2] + pa[3])) + ((pb2[0] + pb2[1]) + (pb2[2] + pb2[3]));
            const float gt = exp2f((float)t * lg), scale = gt / sqrtf(tot * gt * gt * (1.f / 256.f) + RMS_EPS);
            bf16* gp = RG + (row0 + t) * 1024 + hd * 256 + 32 * w + 4 * h;
#pragma unroll
            for (int rg = 0; rg < 4; ++rg) { const v2u g = *(const v2u*)(gp + 8 * rg);
                v2u o; o.x = pkbf(oa[tt][4 * rg] * scale * bflo(g.x), oa[tt][4 * rg + 1] * scale * bfhi(g.x)); o.y = pkbf(oa[tt][4 * rg + 2] * scale * bflo(g.y), oa[tt][4 * rg + 3] * scale * bfhi(g.y));
                *(v2u*)(gp + 8 * rg) = o; }
        }
        if (n + 1 < 32) RT_STORE();
        __syncthreads();
    }
#undef RT_LOAD
#undef RT_STORE
}
constexpr int HG_QP = 272, HG_VP = 288;
constexpr int HG_QOFF = 0, HG_KOFF = 64 * HG_QP, HG_VOFF = 2 * 64 * HG_QP, HG_DOFF = HG_VOFF + 64 * HG_VP, HG_SOFF = HG_DOFF + 2048;
__device__ __forceinline__ void hgrn_unit(unsigned char* ws, const float* ng, int item, LAS unsigned char* sm) {
    int tid_ = threadIdx.x; asm volatile("" : "+v"(tid_));
    const int tid = tid_, lane = tid & 63, w = __builtin_amdgcn_readfirstlane(tid >> 6), g4 = lane >> 4, c15 = lane & 15, p3 = lane & 3;
    const int b = item >> 3, hd = item & 7;
    const bf16* HQ = (const bf16*)(ws + WS_HQ); const bf16* HF = (const bf16*)(ws + WS_HF); const bf16* HI = (const bf16*)(ws + WS_HI); bf16* HG = (bf16*)(ws + WS_OABC) + (size_t)M * D;
    const float* DD = (const float*)(ws + WS_HD);
    LAS float* dimg = (LAS float*)(sm + HG_DOFF); LAS float* part = (LAS float*)(sm + HG_SOFF);
    v4u pq[2], pk[2], pv[2]; float pd;
    const int srow = tid >> 4, sch = tid & 15;
#define HG_LOAD(n_) do { const size_t r0_ = (size_t)b * SEQ + 64 * (n_); \
        _Pragma("unroll") for (int j = 0; j < 2; ++j) { const size_t o_ = (r0_ + srow + 32 * j) * 1024 + hd * 128 + sch * 8; pq[j] = *(const v4u*)(HQ + o_); pk[j] = *(const v4u*)(HF + o_); pv[j] = *(const v4u*)(HI + o_); } \
        pd = DD[(r0_ / 16 + (tid >> 7)) * 1024 + hd * 128 + (tid & 127)]; } while (0)
#define HG_STORE() do { \
        _Pragma("unroll") for (int j = 0; j < 2; ++j) { *(LAS v4u*)(sm + HG_QOFF + (srow + 32 * j) * HG_QP + sch * 16) = pq[j]; *(LAS v4u*)(sm + HG_KOFF + (srow + 32 * j) * HG_QP + sch * 16) = pk[j]; \
            *(LAS v4u*)(sm + HG_VOFF + (srow + 32 * j) * HG_VP + sch * 16) = pv[j]; } \
        dimg[tid] = pd; } while (0)
    HG_LOAD(0); HG_STORE();
    f32x4 sp[8];
#pragma unroll
    for (int i = 0; i < 8; ++i) sp[i] = (f32x4){0.f, 0.f, 0.f, 0.f};
    const f32x4 ngv = *(const f32x4*)(ng + 16 * w + 4 * g4);
    __syncthreads();
    for (int n = 0; n < 32; ++n) {
        const size_t row0 = (size_t)b * SEQ + 64 * n;
        if (n + 1 < 32) HG_LOAD(n + 1);
        f32x4 og[4]; float psum[4];
#pragma unroll
        for (int bk = 0; bk < 4; ++bk) {
            f32x4 at = {0.f, 0.f, 0.f, 0.f};
#pragma unroll
            for (int st = 0; st < 4; ++st) {
                const bf16x8 kf = *(const LAS bf16x8*)(sm + HG_KOFF + (16 * bk + c15) * HG_QP + (32 * st + 8 * g4) * 2);
                const bf16x8 qf = *(const LAS bf16x8*)(sm + HG_QOFF + (16 * bk + c15) * HG_QP + (32 * st + 8 * g4) * 2);
                at = MFMA16(kf, qf, at);
            }
#pragma unroll
            for (int r = 0; r < 4; ++r) if (4 * g4 + r > c15) at[r] = 0.f;
            const v2u atp = (v2u){pkbf(at[0], at[1]), pkbf(at[2], at[3])};
            const bf16x8 bfr = __builtin_bit_cast(bf16x8, ((v4u){atp.x, atp.y, 0u, 0u}));
            const s16x4 vfr4 = lds_tr4(sm + HG_VOFF + (16 * bk + 4 * g4 + (c15 >> 2)) * HG_VP + (16 * w + 4 * p3) * 2);
            const bf16x8 vfr = (bf16x8){vfr4[0], vfr4[1], vfr4[2], vfr4[3], 0, 0, 0, 0};
            f32x4 o = {0.f, 0.f, 0.f, 0.f};
            o = MFMA16(vfr, bfr, o);
#pragma unroll
            for (int I = 0; I < 4; ++I) {
                const v4u ap = (v4u){pkbf(sp[2 * I][0], sp[2 * I][1]), pkbf(sp[2 * I][2], sp[2 * I][3]), pkbf(sp[2 * I + 1][0], sp[2 * I + 1][1]), pkbf(sp[2 * I + 1][2], sp[2 * I + 1][3])};
                const LAS unsigned char* qp = sm + HG_QOFF + (16 * bk + c15) * HG_QP + (32 * I + 4 * g4) * 2;
                const v2u q0 = *(const LAS v2u*)qp, q1 = *(const LAS v2u*)(qp + 32);
                o = MFMA16(__builtin_bit_cast(bf16x8, ap), __builtin_bit_cast(bf16x8, ((v4u){q0.x, q0.y, q1.x, q1.y})), o);
            }
#pragma unroll
            for (int i = 0; i < 8; ++i) {
                const s16x4 kfr4 = lds_tr4(sm + HG_KOFF + (16 * bk + 4 * g4 + (c15 >> 2)) * HG_QP + (16 * i + 4 * p3) * 2);
                sp[i] = MFMA16(((bf16x8){kfr4[0], kfr4[1], kfr4[2], kfr4[3], 0, 0, 0, 0}), vfr, sp[i]);
                sp[i] = sp[i] * *(const LAS f32x4*)(dimg + bk * 128 + 16 * i + 4 * g4);
            }
            og[bk] = o;
            float ss = (o[0] * o[0] + o[1] * o[1]) + (o[2] * o[2] + o[3] * o[3]);
            ss += __shfl_xor(ss, 16); ss += __shfl_xor(ss, 32); psum[bk] = ss;
        }
        if (g4 == 0) {
#pragma unroll
            for (int bk = 0; bk < 4; ++bk) part[(16 * bk + c15) * 8 + w] = psum[bk];
        }
        __syncthreads();
#pragma unroll
        for (int bk = 0; bk < 4; ++bk) {
            const int t = 16 * bk + c15; const f32x4 pa = *(const LAS f32x4*)(part + t * 8), pb2 = *(const LAS f32x4*)(part + t * 8 + 4);
            const float tot = ((pa[0] + pa[1]) + (pa[2] + pa[3])) + ((pb2[0] + pb2[1]) + (pb2[2] + pb2[3]));
            const float rstd = 1.f / sqrtf(tot * (1.f / 128.f) + RMS_EPS);
            bf16* gp = HG + (row0 + t) * 1024 + hd * 128 + 16 * w + 4 * g4; const v2u g = *(const v2u*)gp;
            v2u o; o.x = pkbf(og[bk][0] * rstd * ngv[0] * bflo(g.x), og[bk][1] * rstd * ngv[1] * bfhi(g.x)); o.y = pkbf(og[bk][2] * rstd * ngv[2] * bflo(g.y), og[bk][3] * rstd * ngv[3] * bfhi(g.y));
            *(v2u*)gp = o;
        }
        if (n + 1 < 32) HG_STORE();
        __syncthreads();
    }
#undef HG_LOAD
#undef HG_STORE
}

__device__ __forceinline__ void hgrn_blk_seq(unsigned char* ws, const float* ng, int item, LAS float* sm, int tid) {
    const int b = item >> 3, h = item & 7, dv = tid & 127, kq = tid >> 7, wave = tid >> 6, lane = tid & 63;
    const bf16* HQ = (const bf16*)(ws + WS_HQ); const bf16* HF = (const bf16*)(ws + WS_HF); const bf16* HI = (const bf16*)(ws + WS_HI); bf16* HG = (bf16*)(ws + WS_OABC) + (size_t)M * D;
    const float* DD = (const float*)(ws + WS_HD);
    LAS float* ks = sm; LAS float* qs = sm + 2048; LAS float* part = sm + 4096; LAS float* am = sm + 4096 + 8192; LAS float* ds = am + 256; LAS float* vs = ds + 128;
    float S[32];
#pragma unroll
    for (int i = 0; i < 32; ++i) S[i] = 0.f;
    for (int c0 = 0; c0 < SEQ; c0 += 16) {
        const size_t row0 = (size_t)b * SEQ + c0;
        for (int i = tid; i < 2048; i += 512) { const int t = i >> 7, d = i & 127; ks[i] = bf2f(HF[(row0 + t) * 1024 + h * 128 + d]); qs[i] = bf2f(HQ[(row0 + t) * 1024 + h * 128 + d]); vs[i] = bf2f(HI[(row0 + t) * 1024 + h * 128 + d]); }
        if (tid < 128) ds[tid] = DD[(row0 >> 4) * 1024 + h * 128 + tid];
        __syncthreads();
        if (tid < 256) { const int t = tid >> 4, s = tid & 15; float a = 0.f; if (s <= t) { for (int d = 0; d < 128; ++d) a += qs[t * 128 + d] * ks[s * 128 + d]; } am[tid] = a; }
        __syncthreads();
        for (int t = 0; t < 16; ++t) {
            float po = 0.f;
#pragma unroll
            for (int i = 0; i < 32; ++i) po += qs[t * 128 + kq * 32 + i] * S[i];
            if (kq == 0) { for (int s = 0; s <= t; ++s) po += am[t * 16 + s] * vs[s * 128 + dv]; }
            part[(t * 4 + kq) * 128 + dv] = po;
        }
#pragma unroll
        for (int i = 0; i < 32; ++i) { float u = S[i]; for (int s = 0; s < 16; ++s) u += ks[s * 128 + kq * 32 + i] * vs[s * 128 + dv]; S[i] = u * ds[kq * 32 + i]; }
        __syncthreads();
#pragma unroll
        for (int tt = 0; tt < 2; ++tt) {
            const int t = 2 * wave + tt; float o[2]; float ss = 0.f;
#pragma unroll
            for (int j = 0; j < 2; ++j) { const int c = lane * 2 + j; o[j] = (part[(t * 4) * 128 + c] + part[(t * 4 + 1) * 128 + c]) + (part[(t * 4 + 2) * 128 + c] + part[(t * 4 + 3) * 128 + c]); ss += o[j] * o[j]; }
            const float rstd = 1.f / sqrtf(wave_sum(ss) * (1.f / 128.f) + RMS_EPS);
            bf16* gp = HG + (row0 + t) * 1024 + h * 128 + lane * 2; const unsigned g = *(const unsigned*)gp;
            *(unsigned*)gp = pk2(o[0] * rstd * ng[lane * 2] * bflo(g), o[1] * rstd * ng[lane * 2 + 1] * bfhi(g));
        }
        __syncthreads();
    }
}
#ifndef MK_PHMASK
#define MK_PHMASK 0x3ff
#endif
#define PHEN(j) (((MK_PHMASK) >> (j)) & 1)
constexpr int NPHASES = 19;
#define PHASE_IDS() int tid = threadIdx.x; asm volatile("" : "+v"(tid)); const int lane = tid & 63, wave = __builtin_amdgcn_readfirstlane(tid >> 6); const int gw = vcu * NWAVES + wave; (void)lane; (void)gw
__global__ void __launch_bounds__(NWAVES * 64, 2) mk_fwd(Args args) {
    extern __shared__ __attribute__((aligned(16))) unsigned char lds_raw[];
    LAS unsigned char* lds = (LAS unsigned char*)lds_raw;
    volatile LAS unsigned* MISC = (volatile LAS unsigned*)(lds + MISC_OFF);
    const int G = gridDim.x; const int bx = blockIdx.x;
    const int vcu = (G % 8 == 0) ? (bx % 8) * (G / 8) + bx / 8 : bx;
    const int NGW = G * NWAVES;
    unsigned char* ws = args.ws;
    gu32* ctl = (gu32*)(ws + WS_CTL);
    for (int u = threadIdx.x; u < (LDS_BYTES - LDSCTL_OFF) / 4; u += NWAVES * 64) ((LAS unsigned*)(lds + LDSCTL_OFF))[u] = 0u;
    __syncthreads();
    const int lo = args.ph_lo, hi = args.ph_hi;
    XcdBarrier bar; bar.bar = (unsigned*)(ctl + CW_BAR); bar.x = 0; bar.st = nullptr;
    if (hi - lo > 1) bar = xcd_barrier_post((unsigned*)(ctl + CW_BAR), MISC + 8);
#define IN(k) (lo <= (k) && (k) < hi)
#define SEAM(k) do { if (IN(k) && IN((k) + 1)) xcd_barrier(bar); } while (0)
    float* Hf = args.out;
    bf16* Hb = (bf16*)(ws + WS_HBF);

    if (PHEN(9) && IN(0)) { PHASE_IDS();
        LAS float* scrw = (LAS float*)(lds + RING_OFF + wave * 16384); prologue_convert(scrw, gw, NGW, lane);
        for (int m = gw; m < M; m += NGW) {
            f32x4 v[4];
#pragma unroll
            for (int j = 0; j < 4; ++j) v[j] = *(const f32x4*)(INP(0) + (size_t)m * D + 4 * lane + 256 * j);
            ln_core(v, INP(1), INP(2), lane);
            store_row_f32(Hf + (size_t)m * D, v, lane); store_row_bf16(Hb + (size_t)m * D, v, lane);
        }
        const int gt = vcu * NWAVES * 64 + tid, NGT = G * NWAVES * 64;
        for (int i = gt; i < SEQ * 64; i += NGT) {
            const int t = i >> 6, dd = i & 63;
            const float inv = (float)exp(-9.210340371976184 * ((double)dd / 63.0));
            const float ang = (float)t * inv;
            ((f32x2*)(ws + WS_ROPE))[i] = (f32x2){(float)cos((double)ang), (float)sin((double)ang)};
        }
        for (int i = gt; i < D; i += NGT) {
            const float p0 = INP(5)[i], p1 = INP(5)[D + i];
            ((float*)(ws + WS_LB))[i] = 1.f / (1.f + expf(p0 - p1));
        }
        for (int i = gt; i < MOE_ROWS; i += NGT) ((int*)(ws + WS_RSLOT))[i] = -1;
    }
    SEAM(0);

    for (int l = 0; l < 2; ++l) {
        const int pb = 1 + 9 * l;
        const bf16* Win = (const bf16*)(ws + WS_WIN) + (size_t)l * NIN * D;
        const bf16* Wout = (const bf16*)(ws + WS_WOUT + (size_t)l * 8 * MiB);
        if (PHEN(0) && IN(pb + 0)) { PHASE_IDS();
            pg8::Gemm g{Hb, Win, M, NIN, D}; pg8::StaticOrder S; S.init(M, NIN, G, bx);
            EpiProj E{ws, (const f32x4*)(ws + WS_ROPE), l ? (const float*)(ws + WS_LB) : nullptr};
            pg8::gemm_phase<EpiProj, pg8::StaticOrder, PG8_ALIGN, PG8_SP2>(lds + RING_OFF, g, S, E);
        }
        SEAM(pb + 0);
        if (PHEN(1) && IN(pb + 1)) { PHASE_IDS();
            for (int vb = bx; vb < 256; vb += G) {
                if (vb < 32) {
#ifndef NO_RET
#if MIX_RET_MFMA
                    ret_unit(ws, vb, lds + RING_OFF);
#else
                    ret_seq(ws, vb, (LAS float*)(lds + RING_OFF), tid);
#endif
#endif
                } else if (vb < 96) {
#ifndef NO_HGRN
#if MIX_HGRN_MFMA == 2
                    hgrn_blk_seq(ws, INP(6) + l * 128, vb - 32, (LAS float*)(lds + RING_OFF), tid);
#elif MIX_HGRN_MFMA
                    hgrn_unit(ws, INP(6) + l * 128, vb - 32, lds + RING_OFF);
#else
                    hgrn_seq(ws, l ? (const float*)(ws + WS_LB) : nullptr, INP(6) + l * 128, vb - 32, (LAS float*)(lds + RING_OFF), tid);
#endif
#endif
                } else {
#ifndef NO_SWA
#if MIX_SWA_MFMA
                    for (int it = vb - 96; it < 1024; it += 160) swa_unit(ws, INP(8) + l * 16, it, lds + RING_OFF);
#else
                    for (int it = (vb - 96) * NWAVES + wave; it < 4096; it += 160 * NWAVES) swa_seq(ws, INP(8) + l * 16, it, lane);
#endif
#endif
                }
            }
        }
        SEAM(pb + 1);
        if (PHEN(2) && IN(pb + 2)) { PHASE_IDS();
            pg8::Gemm g{(const bf16*)(ws + WS_OABC), Wout, 3 * M, 3 * D, D}; MergeOrder S; S.S.init(M, D, G, bx);
            EpiMerge E{(const bf16*)(ws + WS_GATES), (float*)(ws + WS_MACC), (bf16*)(ws + WS_MERGED)};
            pg8::gemm_phase<EpiMerge, MergeOrder, PG8_ALIGN, PG8_SP2>(lds + RING_OFF, g, S, E);
        }
        SEAM(pb + 2);
        if (PHEN(3) && IN(pb + 3)) { PHASE_IDS();
            pg8::Gemm g{(const bf16*)(ws + WS_MERGED), Wout + (size_t)3 * D * D, M, D, D}; pg8::StaticOrder S; S.init(M, D, G, bx);
            EpiResid E{Hf};
            pg8::gemm_phase<EpiResid, pg8::StaticOrder, PG8_ALIGN, PG8_SP2>(lds + RING_OFF, g, S, E);
            if (l == 1) { __syncthreads(); LAS float* scrw = (LAS float*)(lds + RING_OFF + wave * 16384); moe_convert(scrw, gw, NGW, lane); }
        }
        SEAM(pb + 3);
        if (PHEN(4) && IN(pb + 4)) { PHASE_IDS();
            const float* g_ = INP(11) + l * D; const float* b_ = INP(12) + l * D;
            for (int m = gw; m < M; m += NGW) {
                f32x4 v[4];
#pragma unroll
                for (int j = 0; j < 4; ++j) v[j] = *(const f32x4*)(Hf + (size_t)m * D + 4 * lane + 256 * j);
                ln_core(v, g_, b_, lane);
                store_row_f32(Hf + (size_t)m * D, v, lane); store_row_bf16(Hb + (size_t)m * D, v, lane);
                if (l == 1) {
                    float lg[NEXP];
#pragma unroll
                    for (int e = 0; e < NEXP; ++e) lg[e] = 0.f;
                    const float* wr_ = INP(16);
#pragma unroll
                    for (int j = 0; j < 4; ++j)
#pragma unroll
                        for (int q = 0; q < 4; ++q) { const float* wp = wr_ + (size_t)(4 * lane + 256 * j + q) * NEXP; const f32x4 w0 = *(const f32x4*)wp, w1 = *(const f32x4*)(wp + 4); const float x = v[j][q];
                            lg[0] += x * w0[0]; lg[1] += x * w0[1]; lg[2] += x * w0[2]; lg[3] += x * w0[3]; lg[4] += x * w1[0]; lg[5] += x * w1[1]; lg[6] += x * w1[2]; lg[7] += x * w1[3]; }
#pragma unroll
                    for (int e = 0; e < NEXP; ++e) lg[e] = wave_sum(lg[e]);
                    int e0 = 0; float l0 = lg[0];
#pragma unroll
                    for (int e = 1; e < NEXP; ++e) if (lg[e] > l0) { l0 = lg[e]; e0 = e; }
                    int e1 = -1; float l1 = -3.0e38f;
#pragma unroll
                    for (int e = 0; e < NEXP; ++e) if (e != e0 && lg[e] > l1) { l1 = lg[e]; e1 = e; }
                    if (lane == 0) {
                        const float p1 = __expf(l1 - l0), w0 = 1.f / (1.f + p1), w1 = p1 * w0;
                        const int pos0 = (int)__hip_atomic_fetch_add(ctl + CW_ECNT + 64 * e0, 1u, RLX_AGENT), pos1 = (int)__hip_atomic_fetch_add(ctl + CW_ECNT + 64 * e1, 1u, RLX_AGENT);
                        ((int*)(ws + WS_TOKI))[4 * m + 0] = e0; ((int*)(ws + WS_TOKI))[4 * m + 1] = pos0; ((int*)(ws + WS_TOKI))[4 * m + 2] = e1; ((int*)(ws + WS_TOKI))[4 * m + 3] = pos1;
                        ((float*)(ws + WS_TOKW))[2 * m] = w0; ((float*)(ws + WS_TOKW))[2 * m + 1] = w1;
                    }
                }
            }
        }
        SEAM(pb + 4);
        if (l == 0) {
            if (PHEN(6) && IN(pb + 6)) { PHASE_IDS();
                pg8::Gemm g{Hb, (const bf16*)(ws + WS_WGU), M, 2 * DFF, D}; pg8::StaticOrder S; S.init(M, 2 * DFF, G, bx);
                EpiSwiglu E{(bf16*)(ws + WS_HID), DFF, 2 * DFF / 256};
                pg8::gemm_phase<EpiSwiglu, pg8::StaticOrder, PG8_ALIGN, PG8_SP2>(lds + RING_OFF, g, S, E);
            }
            SEAM(pb + 6);
            if (PHEN(7) && IN(pb + 7)) { PHASE_IDS();
                pg8::Gemm g{(const bf16*)(ws + WS_HID), (const bf16*)(ws + WS_WDN), M, D, DFF}; pg8::StaticOrder S; S.init(M, D, G, bx);
                EpiResid E{Hf};
                pg8::gemm_phase<EpiResid, pg8::StaticOrder, PG8_ALIGN, PG8_SP2>(lds + RING_OFF, g, S, E);
            }
            SEAM(pb + 7);
            if (PHEN(8) && IN(pb + 8)) { PHASE_IDS();
                const float* g_ = INP(20); const float* b_ = INP(21);
                for (int m = gw; m < M; m += NGW) {
                    f32x4 v[4];
#pragma unroll
                    for (int j = 0; j < 4; ++j) v[j] = *(const f32x4*)(Hf + (size_t)m * D + 4 * lane + 256 * j);
                    ln_core(v, g_, b_, lane);
                    store_row_f32(Hf + (size_t)m * D, v, lane); store_row_bf16(Hb + (size_t)m * D, v, lane);
                }
            }
            SEAM(pb + 8);
        } else {
            const unsigned* ecnt = (const unsigned*)(ctl + CW_ECNT);
            if (PHEN(5) && IN(pb + 5)) { PHASE_IDS();
                int offs[NEXP]; { int p = 0;
#pragma unroll
                    for (int e = 0; e < NEXP; ++e) { offs[e] = p * 256; p += ((int)ecnt[64 * e] + 255) >> 8; } }
                for (int m = gw; m < M; m += NGW) {
                    const int e0 = ((const int*)(ws + WS_TOKI))[4 * m + 0], p0 = ((const int*)(ws + WS_TOKI))[4 * m + 1], e1 = ((const int*)(ws + WS_TOKI))[4 * m + 2], p1 = ((const int*)(ws + WS_TOKI))[4 * m + 3];
                    int r0 = 0, r1 = 0;
#pragma unroll
                    for (int e = 0; e < NEXP; ++e) { if (e == e0) r0 = offs[e] + p0; if (e == e1) r1 = offs[e] + p1; }
                    const v4u a = *(const v4u*)(Hb + (size_t)m * D + 8 * lane), c = *(const v4u*)(Hb + (size_t)m * D + 512 + 8 * lane);
                    bf16* x0 = (bf16*)(ws + WS_XS) + (size_t)r0 * D; bf16* x1 = (bf16*)(ws + WS_XS) + (size_t)r1 * D;
                    *(v4u*)(x0 + 8 * lane) = a; *(v4u*)(x0 + 512 + 8 * lane) = c; *(v4u*)(x1 + 8 * lane) = a; *(v4u*)(x1 + 512 + 8 * lane) = c;
                    if (lane == 0) { ((int*)(ws + WS_RSLOT))[r0] = 2 * m; ((int*)(ws + WS_RSLOT))[r1] = 2 * m + 1;
                        ((float*)(ws + WS_RW))[r0] = ((const float*)(ws + WS_TOKW))[2 * m]; ((float*)(ws + WS_RW))[r1] = ((const float*)(ws + WS_TOKW))[2 * m + 1]; }
                }
            }
            SEAM(pb + 5);
            if (PHEN(6) && IN(pb + 6)) { PHASE_IDS();
                pg8::Gemm g{(const bf16*)(ws + WS_XS), (const bf16*)(ws + WS_WGUE), MOE_ROWS, NEXP * 2 * DEXP, D}; MoeOrder S; S.init(ecnt, 2 * DEXP / 256, G, bx);
                EpiSwiglu E{(bf16*)(ws + WS_HIDE), DEXP, 2 * DEXP / 256};
                pg8::gemm_phase<EpiSwiglu, MoeOrder, PG8_ALIGN, PG8_SP2>(lds + RING_OFF, g, S, E);
            }
            SEAM(pb + 6);
            if (PHEN(7) && IN(pb + 7)) { PHASE_IDS();
                pg8::Gemm g{(const bf16*)(ws + WS_HIDE), (const bf16*)(ws + WS_WDNE), MOE_ROWS, NEXP * D, DEXP}; MoeOrder S; S.init(ecnt, D / 256, G, bx);
                EpiMoeDown E{(bf16*)(ws + WS_YS), (const int*)(ws + WS_RSLOT), (const float*)(ws + WS_RW)};
                pg8::gemm_phase<EpiMoeDown, MoeOrder, PG8_ALIGN, PG8_SP2>(lds + RING_OFF, g, S, E);
            }
            SEAM(pb + 7);
            if (PHEN(8) && IN(pb + 8)) { PHASE_IDS();
                const float* g_ = INP(20) + D; const float* b_ = INP(21) + D; const bf16* YS = (const bf16*)(ws + WS_YS);
                for (int m = gw; m < M; m += NGW) {
                    f32x4 v[4];
#pragma unroll
                    for (int j = 0; j < 4; ++j) {
                        const f32x4 h = *(const f32x4*)(Hf + (size_t)m * D + 4 * lane + 256 * j);
                        const v2u y0 = *(const v2u*)(YS + (size_t)(2 * m) * D + 4 * lane + 256 * j), y1 = *(const v2u*)(YS + (size_t)(2 * m + 1) * D + 4 * lane + 256 * j);
                        const f32x4 a = (f32x4){bflo(y0.x), bfhi(y0.x), bflo(y0.y), bfhi(y0.y)}, c = (f32x4){bflo(y1.x), bfhi(y1.x), bflo(y1.y), bfhi(y1.y)};
                        v[j] = h * DN_ALPHA + (a + c);
                    }
                    ln_core(v, g_, b_, lane);
                    store_row_f32(Hf + (size_t)m * D, v, lane);
                }
            }
        }
    }
#undef IN
#undef SEAM
}

extern "C" void kernel_launch(void* const* d_in, const int* in_sizes, int n_in, void* d_out, int out_size, void* d_ws, size_t ws_size, hipStream_t stream) {
    static int grid = 0;
    if (grid == 0) {
        if (n_in != 22 || out_size != M * D || ws_size < WS_END) { fprintf(stderr, "kernel_launch: unexpected problem shape (n_in %d, out %d, ws %zu); nothing launched\n", n_in, out_size, ws_size); grid = -1; return; }
        int dev = 0, cus = 0, per_cu = 0;
        if (hipGetDevice(&dev) != hipSuccess || hipDeviceGetAttribute(&cus, hipDeviceAttributeMultiprocessorCount, dev) != hipSuccess) { grid = -1; return; }
        if (hipFuncSetAttribute((const void*)mk_fwd, hipFuncAttributeMaxDynamicSharedMemorySize, LDS_BYTES) != hipSuccess) { fprintf(stderr, "kernel_launch: hipFuncSetAttribute failed\n"); grid = -1; return; }
        if (hipOccupancyMaxActiveBlocksPerMultiprocessor(&per_cu, (const void*)mk_fwd, NWAVES * 64, LDS_BYTES) != hipSuccess || per_cu < 1) { fprintf(stderr, "kernel_launch: occupancy query says %d\n", per_cu); }
        (void)hipGetLastError();
        grid = cus;
    }
    if (grid < 0) return;
    if (hipMemsetAsync((char*)d_ws + WS_CTL, 0, CTL_ZERO_BYTES, stream) != hipSuccess) return;
    Args a{};
    for (int i = 0; i < 22; ++i) a.in[i] = (const float*)d_in[i];
    a.out = (float*)d_out; a.ws = (unsigned char*)d_ws;
#if MK_SINGLE
    a.ph_lo = 0; a.ph_hi = NPHASES;
    hipLaunchKernelGGL(mk_fwd, dim3(grid), dim3(NWAVES * 64), LDS_BYTES, stream, a);
#else
    for (int p = 0; p < NPHASES; ++p) {
        if (p == 6) continue;
        a.ph_lo = p; a.ph_hi = p + 1;
        hipLaunchKernelGGL(mk_fwd, dim3(grid), dim3(NWAVES * 64), LDS_BYTES, stream, a);
    }
#endif
}
```

```cpp
#include <hip/hip_runtime.h>
#include <cstdio>
#include <cstdint>
#ifndef MK_SINGLE
#define MK_SINGLE 1
#endif
#ifndef MIX_SWA_MFMA
#define MIX_SWA_MFMA 1
#endif
#ifndef MIX_RET_MFMA
#define MIX_RET_MFMA 1
#endif
#ifndef MIX_HGRN_MFMA
#define MIX_HGRN_MFMA 1
#endif
#ifndef MIX_PROBE_DUP
#define MIX_PROBE_DUP 0
#endif
namespace pg8 {
#define PG8_LAS __attribute__((address_space(3)))
typedef unsigned short bf16_t;
typedef short bf16x8 __attribute__((ext_vector_type(8)));
typedef float f32x4 __attribute__((ext_vector_type(4)));
typedef unsigned u32x4 __attribute__((ext_vector_type(4)));
constexpr int BM = 256, BK = 64, HALF = 128, HTB = HALF * BK * 2  , STAGE_BYTES = 8 * HTB, NXCD = 8, WGM = 8;

__host__ __device__ __forceinline__ int lds_byte(int r, int c) { const int st = (r >> 4) * 2 + (c >> 5), rr = r & 15, cc = c & 31, ob = rr * 64 + cc * 2; return st * 1024 + (ob ^ (((ob >> 9) & 1) << 5)); }
__host__ __device__ __forceinline__ void stage_rc(int b, int& R, int& C) { const int st = b / 1024, sb = b % 1024, swz = sb ^ (((sb >> 9) & 1) << 5); R = (st >> 1) * 16 + swz / 64; C = (st & 1) * 32 + (swz % 64) / 2; }
__host__ __device__ __forceinline__ int perm32(int rho) { const int n = rho >> 4, i = rho & 15; return 8 * (i >> 2) + 4 * n + (i & 3); }

struct Unit { int pm, pn; };
struct Gemm { const bf16_t* A; const bf16_t* Bt; int M, N, K; };

struct StaticOrder {
    int nM, nN, nwg, G, c;
    __host__ __device__ void init(int M, int N, int G_, int c_) { nM = M / BM; nN = N / BM; nwg = nM * nN; G = G_; c = c_; }
    __host__ __device__ bool next(int i, Unit& u) const {
        const long L = (long)i * G + c; if (L >= nwg) return false;
        int wgid = (int)L; { const int q = nwg / NXCD, r = nwg % NXCD, xcd = wgid % NXCD, off = wgid / NXCD; wgid = (xcd < r ? xcd * (q + 1) : r * (q + 1) + (xcd - r) * q) + off; }
        const int nig = WGM * nN, gid = wgid / nig, fm = gid * WGM, gsz = (nM - fm) < WGM ? (nM - fm) : WGM;
        u.pm = fm + ((wgid % nig) % gsz); u.pn = (wgid % nig) / gsz; return true;
    }
    __device__ __forceinline__ void a_ready(const Unit&) const {}
    __device__ __forceinline__ void done(const Unit&) const {}
};
__device__ __forceinline__ unsigned cvt_pk_bf16(float lo, float hi) { unsigned r; asm volatile("v_cvt_pk_bf16_f32 %0, %1, %2" : "=v"(r) : "v"(lo), "v"(hi)); return r; }
typedef float f32x2 __attribute__((ext_vector_type(2)));
template <class Epi, class Sched, bool ALIGN_EPI = false, bool SP2 = false>
__device__ __forceinline__ void gemm_phase(PG8_LAS unsigned char* lds, const Gemm g, const Sched& S, const Epi& E) {
    int tid_ = threadIdx.x; asm volatile("" : "+v"(tid_));
    const int tid = tid_, wid = __builtin_amdgcn_readfirstlane(tid >> 6), lane = tid & 63, wr = wid >> 2, wc = wid & 3, fr = lane & 15, fq = lane >> 4;
    const int K = g.K, nt = K / BK;
    unsigned voffA[2], voffB[2];
#pragma unroll
    for (int i = 0; i < 2; ++i) { int R, C; stage_rc(tid * 16 + i * 8192, R, C); const int Rb = Epi::PERM ? ((R & ~31) + perm32(R & 31)) : R;
        voffA[i] = (unsigned)(R * K + C) * 2u; voffB[i] = (unsigned)(Rb * K + C) * 2u; }
    const size_t kstep = (size_t)(BK * 2);
    const size_t hstep = (size_t)HALF * K * 2;
    const size_t tstep = 2 * hstep;
    const unsigned ldsw = (unsigned)wid * 1024u;
    const int aoff = lds_byte(wr * 64 + fr, fq * 8), boff = lds_byte(wc * 32 + fr, fq * 8);
#define PG8_SA(b, h) (((b) * 2 + (h)) * HTB)
#define PG8_SB(b, h) ((4 + (b) * 2 + (h)) * HTB)
#define PG8_STAGE(bufoff, gbase, voff) do { _Pragma("unroll") for (int _i = 0; _i < 2; ++_i) \
        __builtin_amdgcn_global_load_lds((const unsigned*)((const char*)(gbase) + (voff)[_i]), (PG8_LAS unsigned*)(lds + (bufoff) + ldsw + _i * 8192), 16, 0, 0); } while (0)
#define PG8_LDA(dst, b, h) do { _Pragma("unroll") for (int m = 0; m < 4; ++m) _Pragma("unroll") for (int k = 0; k < 2; ++k) dst[m][k] = *(const PG8_LAS bf16x8*)(lds + PG8_SA(b, h) + aoff + m * 2048 + k * 1024); } while (0)
#define PG8_LDB(dst, b, h) do { _Pragma("unroll") for (int n = 0; n < 2; ++n) _Pragma("unroll") for (int k = 0; k < 2; ++k) dst[n][k] = *(const PG8_LAS bf16x8*)(lds + PG8_SB(b, h) + boff + n * 2048 + k * 1024); } while (0)
#define PG8_MMA(ai, bj, At, Bt) do { __builtin_amdgcn_s_setprio(1); _Pragma("unroll") for (int m = 0; m < 4; ++m) _Pragma("unroll") for (int n = 0; n < 2; ++n) _Pragma("unroll") for (int k = 0; k < 2; ++k) \
        acc[ai][bj][m][n] = __builtin_amdgcn_mfma_f32_16x16x32_bf16(Bt[n][k], At[m][k], acc[ai][bj][m][n], 0, 0, 0); __builtin_amdgcn_s_setprio(0); } while (0)
#define PG8_WAIT_V(n) asm volatile("s_waitcnt vmcnt(" #n ")" ::: "memory")
#define PG8_WAIT_L(n) asm volatile("s_waitcnt lgkmcnt(" #n ")" ::: "memory")
#define PG8_BAR __builtin_amdgcn_s_barrier()
#define PG8_SCHED __builtin_amdgcn_sched_barrier(0)
    Unit cur, nxt; int ui = 0;
    if (!S.next(0, cur)) return;
    f32x4 acc[2][2][4][2];
#pragma unroll
    for (int a = 0; a < 2; ++a)
#pragma unroll
        for (int b = 0; b < 2; ++b)
#pragma unroll
            for (int m = 0; m < 4; ++m)
#pragma unroll
                for (int n = 0; n < 2; ++n) acc[a][b][m][n] = (f32x4){0.f, 0.f, 0.f, 0.f};
    bf16x8 At[4][2], B0[2][2], B1[2][2];
    const char* cA = (const char*)g.A + (size_t)cur.pm * tstep; const char* cB = (const char*)g.Bt + (size_t)cur.pn * tstep;
    S.a_ready(cur);
    if constexpr (SP2) {
        PG8_STAGE(PG8_SB(0, 0), cB, voffB); PG8_STAGE(PG8_SB(0, 1), cB + hstep, voffB); PG8_STAGE(PG8_SA(0, 0), cA, voffA); PG8_STAGE(PG8_SA(0, 1), cA + hstep, voffA);
        if (wr == 1) PG8_BAR;
        PG8_WAIT_V(2); PG8_BAR;
        PG8_STAGE(PG8_SB(1, 0), cB + kstep, voffB); PG8_STAGE(PG8_SA(1, 0), cA + kstep, voffA); PG8_STAGE(PG8_SB(1, 1), cB + hstep + kstep, voffB);
        PG8_WAIT_V(6); PG8_BAR;
    } else {
        PG8_STAGE(PG8_SB(0, 0), cB, voffB); PG8_STAGE(PG8_SA(0, 0), cA, voffA); PG8_STAGE(PG8_SB(0, 1), cB + hstep, voffB); PG8_STAGE(PG8_SA(0, 1), cA + hstep, voffA);
        if (wr == 1) PG8_BAR;
        PG8_WAIT_V(4); PG8_BAR;
        PG8_STAGE(PG8_SB(1, 0), cB + kstep, voffB); PG8_STAGE(PG8_SA(1, 0), cA + kstep, voffA); PG8_STAGE(PG8_SB(1, 1), cB + hstep + kstep, voffB);
        PG8_WAIT_V(6); PG8_BAR;
    }
    for (;;) {
        const bool has_next = S.next(ui + 1, nxt);
        const char* nA = has_next ? (const char*)g.A + (size_t)nxt.pm * tstep : cA; const char* nB = has_next ? (const char*)g.Bt + (size_t)nxt.pn * tstep : cB;
        for (int t = 0; t < nt; t += 2) {
            const bool last = (t == nt - 2);
            const char* a1 = cA + (size_t)(t + 1) * kstep;
            const char* a2 = last ? nA : cA + (size_t)(t + 2) * kstep; const char* b2 = last ? nB : cB + (size_t)(t + 2) * kstep;
            const char* a3 = a2 + kstep; const char* b3 = b2 + kstep;
            if (last && has_next) S.a_ready(nxt);
            if constexpr (SP2) {
            PG8_LDB(B0, 0, 0); PG8_LDB(B1, 0, 1); PG8_SCHED; PG8_LDA(At, 0, 0); PG8_STAGE(PG8_SA(1, 1), a1 + hstep, voffA);
            PG8_WAIT_V(8); PG8_WAIT_L(0); PG8_BAR; PG8_MMA(0, 0, At, B0); PG8_MMA(0, 1, At, B1); PG8_BAR; PG8_SCHED;
            PG8_LDA(At, 0, 1); PG8_STAGE(PG8_SB(0, 0), b2, voffB); PG8_STAGE(PG8_SB(0, 1), b2 + hstep, voffB); PG8_STAGE(PG8_SA(0, 0), a2, voffA);
            PG8_WAIT_V(8); PG8_WAIT_L(0); PG8_BAR; PG8_MMA(1, 0, At, B0); PG8_MMA(1, 1, At, B1); PG8_BAR; PG8_SCHED;
            PG8_LDB(B0, 1, 0); PG8_LDB(B1, 1, 1); PG8_SCHED; PG8_LDA(At, 1, 0); PG8_STAGE(PG8_SA(0, 1), a2 + hstep, voffA);
            PG8_WAIT_V(8); PG8_WAIT_L(0); PG8_BAR; PG8_MMA(0, 0, At, B0); PG8_MMA(0, 1, At, B1); PG8_BAR; PG8_SCHED;
            PG8_LDA(At, 1, 1); PG8_STAGE(PG8_SB(1, 0), b3, voffB); PG8_STAGE(PG8_SB(1, 1), b3 + hstep, voffB); PG8_STAGE(PG8_SA(1, 0), a3, voffA);
            PG8_WAIT_V(8); PG8_WAIT_L(0); PG8_BAR; PG8_MMA(1, 0, At, B0); PG8_MMA(1, 1, At, B1); PG8_BAR; PG8_SCHED;
            } else {
            PG8_LDB(B0, 0, 0); PG8_SCHED; PG8_LDA(At, 0, 0); PG8_STAGE(PG8_SA(1, 1), a1 + hstep, voffA);
            PG8_WAIT_L(8); PG8_BAR; PG8_WAIT_L(0); PG8_MMA(0, 0, At, B0); PG8_BAR; PG8_SCHED;
            PG8_LDB(B1, 0, 1); PG8_STAGE(PG8_SB(0, 0), b2, voffB);
            PG8_BAR; PG8_WAIT_L(0); PG8_MMA(0, 1, At, B1); PG8_BAR;
            PG8_LDA(At, 0, 1); PG8_STAGE(PG8_SA(0, 0), a2, voffA);
            PG8_BAR; PG8_WAIT_L(0); PG8_MMA(1, 0, At, B0); PG8_BAR; PG8_SCHED;
            PG8_STAGE(PG8_SB(0, 1), b2 + hstep, voffB);
            PG8_WAIT_V(6); PG8_BAR; PG8_MMA(1, 1, At, B1); PG8_BAR;
            PG8_LDB(B0, 1, 0); PG8_SCHED; PG8_LDA(At, 1, 0); PG8_STAGE(PG8_SA(0, 1), a2 + hstep, voffA);
            PG8_WAIT_L(8); PG8_BAR; PG8_WAIT_L(0); PG8_MMA(0, 0, At, B0); PG8_BAR; PG8_SCHED;
            PG8_LDB(B1, 1, 1); PG8_STAGE(PG8_SB(1, 0), b3, voffB);
            PG8_BAR; PG8_WAIT_L(0); PG8_MMA(0, 1, At, B1); PG8_BAR;
            PG8_LDA(At, 1, 1); PG8_STAGE(PG8_SA(1, 0), a3, voffA);
            PG8_BAR; PG8_WAIT_L(0); PG8_MMA(1, 0, At, B0); PG8_BAR; PG8_SCHED;
            PG8_STAGE(PG8_SB(1, 1), b3 + hstep, voffB);
            PG8_WAIT_V(6); PG8_BAR; PG8_MMA(1, 1, At, B1); PG8_BAR;
            }
        }
        if constexpr (ALIGN_EPI) { if (wr == 0) PG8_BAR; }
        if constexpr (!Epi::AFTER_DRAIN) { E(acc, cur, wr, wc, fr, fq); S.done(cur); }
        if (!has_next) break;
#pragma unroll
        for (int a = 0; a < 2; ++a)
#pragma unroll
            for (int b = 0; b < 2; ++b)
#pragma unroll
                for (int m = 0; m < 4; ++m)
#pragma unroll
                    for (int n = 0; n < 2; ++n) acc[a][b][m][n] = (f32x4){0.f, 0.f, 0.f, 0.f};
        cur = nxt; cA = nA; cB = nB; ++ui;
        if constexpr (ALIGN_EPI) { if (wr == 1) PG8_BAR; }
    }
    PG8_WAIT_V(0);
    if constexpr (!ALIGN_EPI) { if (wr == 0) PG8_BAR; }
    PG8_BAR;
    if constexpr (Epi::AFTER_DRAIN) { E.fused(acc, cur, wr, wc, fr, fq, lds, wid, lane); S.done(cur); }
#undef PG8_SA
#undef PG8_SB
#undef PG8_STAGE
#undef PG8_LDA
#undef PG8_LDB
#undef PG8_MMA
#undef PG8_WAIT_V
#undef PG8_WAIT_L
#undef PG8_BAR
#undef PG8_SCHED
}
}
#ifndef PG8_SP2
#define PG8_SP2 true
#endif
#ifndef PG8_ALIGN
#define PG8_ALIGN true
#endif
#define GAS __attribute__((address_space(1)))
#define LAS __attribute__((address_space(3)))
typedef unsigned short bf16;
typedef unsigned v4u __attribute__((ext_vector_type(4)));
typedef unsigned v2u __attribute__((ext_vector_type(2)));
typedef float f32x4 __attribute__((ext_vector_type(4)));
typedef float f32x2 __attribute__((ext_vector_type(2)));
typedef GAS unsigned gu32;
#define RLX_AGENT __ATOMIC_RELAXED, __HIP_MEMORY_SCOPE_AGENT
#define LDS_WAIT() asm volatile("s_waitcnt lgkmcnt(0)" ::: "memory")
#define VM_WAIT() asm volatile("s_waitcnt vmcnt(0)" ::: "memory")
__device__ __forceinline__ unsigned f2bf(float f) { unsigned u = __builtin_bit_cast(unsigned, f); return (u + 0x7fffu + ((u >> 16) & 1u)) >> 16; }
__device__ __forceinline__ unsigned pk2(float lo, float hi) { return f2bf(lo) | (f2bf(hi) << 16); }
__device__ __forceinline__ float bf2f(unsigned short b) { return __builtin_bit_cast(float, ((unsigned)b) << 16); }
__device__ __forceinline__ float bflo(unsigned w) { return __builtin_bit_cast(float, w << 16); }
__device__ __forceinline__ float bfhi(unsigned w) { return __builtin_bit_cast(float, w & 0xffff0000u); }
__device__ __forceinline__ float fsigmoid(float x) { return __builtin_amdgcn_rcpf(1.f + __expf(-x)); }
__device__ __forceinline__ float fsilu(float x) { return x * fsigmoid(x); }
__device__ __forceinline__ float wave_sum(float v) {
#pragma unroll
    for (int o = 1; o < 64; o <<= 1) v += __shfl_xor(v, o);
    return v;
}
typedef __bf16 bf16x2_t __attribute__((ext_vector_type(2)));
__device__ __forceinline__ unsigned pkbf(float a, float b) { f32x2 v = {a, b}; bf16x2_t r = __builtin_convertvector(v, bf16x2_t); return __builtin_bit_cast(unsigned, r); }
#define XB_TMO      128
#define XB_XCNT(j)  (256  + 64 * (j))
#define XB_XSUB(j)  (1280 + 64 * (j))
#define XB_XGEN(j)  (2304 + 64 * (j))
#define XB_TOP      3328
#define XB_TOPGEN   3392
#define XCD_BAR_WORDS 3456
#define XB_SPIN_CAP (1u << 18)

__device__ __forceinline__ unsigned xb_ld(unsigned* p)              { return __hip_atomic_load(p, __ATOMIC_RELAXED, __HIP_MEMORY_SCOPE_AGENT); }
__device__ __forceinline__ unsigned xb_add(unsigned* p, unsigned v) { return __hip_atomic_fetch_add(p, v, __ATOMIC_RELAXED, __HIP_MEMORY_SCOPE_AGENT); }
__device__ __forceinline__ unsigned xb_xcc_id() { return (unsigned)__builtin_amdgcn_s_getreg((3 << 11) | 20) & 0xFu; }
#define XB_SPIN(cond, bar) do { unsigned _sp = 0; while (cond) { __builtin_amdgcn_s_sleep(1); \
    if ((++_sp & 255u) == 0u) { if (xb_ld(&(bar)[XB_TMO])) break; if (_sp > XB_SPIN_CAP) { atomicAdd(&(bar)[XB_TMO], 1u); break; } } } } while (0)

struct XcdBarrier {
    unsigned* bar; unsigned x;
    volatile LAS unsigned* st;
};

__device__ __forceinline__ XcdBarrier xcd_barrier_post(unsigned* bar, volatile LAS unsigned* st) {
    XcdBarrier b; b.bar = bar; b.x = xb_xcc_id(); b.st = st;
    if (threadIdx.x == 0) (void)xb_add(&bar[XB_XCNT(b.x)], 1u);
    return b;
}
__device__ __forceinline__ void xcd_barrier_complete(unsigned* bar, unsigned x, unsigned& nloc, unsigned& nx) {
    const unsigned G = gridDim.x * gridDim.y * gridDim.z;
    unsigned sum, cnt, mine, sp = 0u;
    for (;;) {
        sum = 0u; cnt = 0u; mine = 0u;
#pragma unroll
        for (unsigned j = 0; j < 16; ++j) { const unsigned c = xb_ld(&bar[XB_XCNT(j)]); sum += c; cnt += (c > 0u) ? 1u : 0u; mine = (j == x) ? c : mine; }
        if (sum == G) break;
        __builtin_amdgcn_s_sleep(1);
        if ((++sp & 255u) == 0u) { if (xb_ld(&bar[XB_TMO])) break; if (sp > XB_SPIN_CAP) { atomicAdd(&bar[XB_TMO], 1u); break; } }
    }
    nloc = mine > 0u ? mine : 1u; nx = cnt > 0u ? cnt : 1u;
}

__device__ __forceinline__ void xcd_barrier(const XcdBarrier& b) {
    asm volatile("s_waitcnt vmcnt(0)" ::: "memory");
    __syncthreads();
    if (threadIdx.x == 0) {
        unsigned* bar = b.bar;
        __builtin_amdgcn_s_waitcnt(0);
        unsigned nloc = b.st[0], nx = b.st[1];
        if (nloc == 0u) { xcd_barrier_complete(bar, b.x, nloc, nx); b.st[0] = nloc; b.st[1] = nx; }
        const unsigned old = xb_add(&bar[XB_XSUB(b.x)], 1u);
        const unsigned gen = old / nloc;
        if (old + 1u == (gen + 1u) * nloc) {
            __builtin_amdgcn_fence(__ATOMIC_RELEASE, "agent");
            asm volatile("s_waitcnt vmcnt(0)" ::: "memory");
            const unsigned og = xb_add(&bar[XB_TOP], 1u);
            const unsigned tg = og / nx;
            if (og + 1u == (tg + 1u) * nx) xb_add(&bar[XB_TOPGEN], 1u);
            else XB_SPIN(xb_ld(&bar[XB_TOPGEN]) == tg, bar);
            __builtin_amdgcn_fence(__ATOMIC_ACQUIRE, "agent");
            xb_add(&bar[XB_XGEN(b.x)], 1u);
            asm volatile("s_waitcnt vmcnt(0)" ::: "memory");
        } else {
            XB_SPIN(xb_ld(&bar[XB_XGEN(b.x)]) == gen, bar);
            __builtin_amdgcn_fence(__ATOMIC_ACQUIRE, "agent");
            asm volatile("s_waitcnt vmcnt(0)" ::: "memory");
        }
    }
    __syncthreads();
}
constexpr int NWAVES = 8;
constexpr int D = 1024, SEQ = 2048, M = 16384, NIN = 11776, DFF = 2816, NEXP = 8, DEXP = 3584;
constexpr int MOE_ROWS = 136 * 256;
constexpr float DN_ALPHA = 1.41421356237309515f;
constexpr float LN_EPS = 1e-5f, RMS_EPS = 1e-6f;
constexpr size_t MiB = 1u << 20;
constexpr size_t WS_CTL = 0, CTL_ZERO_BYTES = 1 * MiB;
constexpr size_t WS_ROPE = 1 * MiB;
constexpr size_t WS_LB = 2 * MiB;
constexpr size_t WS_TOKI = WS_LB + 65536;
constexpr size_t WS_TOKW = WS_TOKI + (size_t)M * 16;
constexpr size_t WS_RSLOT = WS_TOKW + (size_t)M * 8;
constexpr size_t WS_RW = WS_RSLOT + (size_t)MOE_ROWS * 4;
static_assert(WS_RW + (size_t)MOE_ROWS * 4 <= 4 * MiB, "misc tables");
constexpr size_t WS_WIN = 4 * MiB;
constexpr size_t WS_WOUT = 50 * MiB;
constexpr size_t WS_WGU = 66 * MiB;
constexpr size_t WS_WDN = 77 * MiB;
constexpr size_t WS_HBF = 84 * MiB;
constexpr size_t WS_RQ = 116 * MiB, WS_RK = 132 * MiB, WS_RV = 148 * MiB;
constexpr size_t WS_MACC = 116 * MiB;
constexpr size_t WS_OABC = 180 * MiB;
constexpr size_t WS_GATES = 276 * MiB;
constexpr size_t WS_HQ = 372 * MiB, WS_HF = 404 * MiB, WS_HI = 436 * MiB;
constexpr size_t WS_SK = 468 * MiB, WS_SV = 476 * MiB;
constexpr size_t WS_MERGED = 484 * MiB;
constexpr size_t WS_HID = 180 * MiB;
constexpr size_t WS_WGUE = 116 * MiB;
constexpr size_t WS_WDNE = 228 * MiB;
constexpr size_t WS_HIDE = 284 * MiB;
constexpr size_t WS_XS = 4 * MiB;
constexpr size_t WS_YS = 116 * MiB;
constexpr size_t WS_HD = 520 * MiB;
constexpr size_t WS_END = WS_HIDE + (size_t)MOE_ROWS * DEXP * 2;
static_assert(WS_END <= 557 * MiB, "workspace");
static_assert(WS_XS + (size_t)MOE_ROWS * D * 2 <= WS_HBF, "XS");
constexpr int CW_TMO = 0, CW_BAR = 4096, CW_ECNT = 8192;

constexpr int RING_OFF = 0, RING_BYTES = 131072;
constexpr int LDSCTL_OFF = RING_BYTES, MISC_OFF = LDSCTL_OFF + 320;
constexpr int LDS_BYTES = 147456;

using pg8::Unit;
__device__ __forceinline__ v4u pack8(const f32x4& a, const f32x4& b) {
    v4u w; w.x = pg8::cvt_pk_bf16(a[0], a[1]); w.y = pg8::cvt_pk_bf16(a[2], a[3]); w.z = pg8::cvt_pk_bf16(b[0], b[1]); w.w = pg8::cvt_pk_bf16(b[2], b[3]); return w;
}
struct EpiProj {
    static constexpr bool PERM = true, AFTER_DRAIN = false;
    unsigned char* ws; const f32x4* rope; const float* lb;
    __device__ __forceinline__ void operator()(const f32x4 (&acc)[2][2][4][2], const Unit& u, int wr, int wc, int fr, int fq) const {
        const int pn = u.pn; const int row0 = u.pm * 256 + wr * 64 + fr;
#if MIX_HGRN_MFMA
        if (pn >= 12 && pn < 20) {
            const int hd = pn - 12, dk0 = wc * 32 + 8 * fq;
            bf16* HQ = (bf16*)(ws + WS_HQ); bf16* HF = (bf16*)(ws + WS_HF); float* DD = (float*)(ws + WS_HD);
            f32x4 lbv[2];
#pragma unroll
            for (int n = 0; n < 2; ++n) lbv[n] = lb ? *(const f32x4*)(lb + hd * 128 + dk0 + 4 * n) : (f32x4){0.f, 0.f, 0.f, 0.f};
#pragma unroll
            for (int ai = 0; ai < 2; ++ai)
#pragma unroll
                for (int m = 0; m < 4; ++m) {
                    const int row = row0 + ai * 128 + m * 16; f32x4 qt[2], kt[2], dd[2];
#pragma unroll
                    for (int n = 0; n < 2; ++n)
#pragma unroll
                        for (int j = 0; j < 4; ++j) {
                            const float q = acc[ai][0][m][n][j], z = acc[ai][1][m][n][j], l = lbv[n][j];
                            const float f = l + (1.f - l) * fsigmoid(z);
                            float bs = __logf(f);
                            bs += __builtin_bit_cast(float, __builtin_amdgcn_update_dpp(0, __builtin_bit_cast(int, bs), 0x111, 0xf, 0xf, true));
                            bs += __builtin_bit_cast(float, __builtin_amdgcn_update_dpp(0, __builtin_bit_cast(int, bs), 0x112, 0xf, 0xf, true));
                            bs += __builtin_bit_cast(float, __builtin_amdgcn_update_dpp(0, __builtin_bit_cast(int, bs), 0x114, 0xf, 0xf, true));
                            bs += __builtin_bit_cast(float, __builtin_amdgcn_update_dpp(0, __builtin_bit_cast(int, bs), 0x118, 0xf, 0xf, true));
                            const float eb = __expf(bs);
                            qt[n][j] = q * eb; kt[n][j] = (1.f - f) * __expf(-bs); dd[n][j] = eb;
                        }
                    const size_t o = (size_t)row * 1024 + hd * 128 + dk0;
                    *(v4u*)(HQ + o) = pack8(qt[0], qt[1]); *(v4u*)(HF + o) = pack8(kt[0], kt[1]);
                    if (fr == 15) { float* dp = DD + (size_t)(row >> 4) * 1024 + hd * 128 + dk0; *(f32x4*)dp = dd[0]; *(f32x4*)(dp + 4) = dd[1]; }
                }
            return;
        }
#endif
        if (pn < 4) {
            bf16* dst = (bf16*)(ws + (pn < 2 ? WS_RQ : WS_RK)); const float sc0 = pn < 2 ? 1.f : 0.08838834764831845f;
            const float nlg = pn < 2 ? 0.f : -log2f(1.f - exp2f(-5.f - (float)(2 * (pn & 1) + (wc >> 1))));
            const int dd0 = (wc & 1) * 32 + 8 * fq, colb = (2 * (pn & 1) + (wc >> 1)) * 128 + dd0;
#pragma unroll
            for (int ai = 0; ai < 2; ++ai)
#pragma unroll
                for (int m = 0; m < 4; ++m) {
                    const int row = row0 + ai * 128 + m * 16, t = row & (SEQ - 1);
                    const float sc = sc0 * exp2f((float)(row & 63) * nlg);
                    const f32x4* rp = rope + ((size_t)t * 64 + dd0) / 2;
                    f32x4 o1[2], o2[2];
#pragma unroll
                    for (int n = 0; n < 2; ++n) {
                        const f32x4 ra = rp[2 * n], rb = rp[2 * n + 1];
                        const f32x4 c = (f32x4){ra[0], ra[2], rb[0], rb[2]}, s = (f32x4){ra[1], ra[3], rb[1], rb[3]};
                        const f32x4 x1 = acc[ai][0][m][n], x2 = acc[ai][1][m][n];
                        o1[n] = (x1 * c - x2 * s) * sc; o2[n] = (x1 * s + x2 * c) * sc;
                    }
                    bf16* rowp = dst + (size_t)row * 512 + colb;
                    *(v4u*)rowp = pack8(o1[0], o1[1]); *(v4u*)(rowp + 64) = pack8(o2[0], o2[1]);
                }
            return;
        }
        size_t off; int ldc = 1024, c0, mode = 0;
        if (pn < 8) { off = WS_RV; c0 = pn - 4; }
        else if (pn < 12) { off = WS_OABC; c0 = pn - 8; mode = 1; }
        else if (pn < 16) { off = WS_HQ; c0 = pn - 12; }
        else if (pn < 20) { off = WS_HF; c0 = pn - 16; }
        else if (pn < 24) { off = WS_HI; c0 = pn - 20; }
        else if (pn < 28) { off = WS_OABC + (size_t)M * D * 2; c0 = pn - 24; mode = 1; }
        else if (pn < 32) { off = WS_OABC + (size_t)M * D * 4; c0 = pn - 28; mode = 3; }
        else if (pn < 33) { off = WS_SK; c0 = 0; ldc = 256; }
        else if (pn < 34) { off = WS_SV; c0 = 0; ldc = 256; }
        else { const int g = (pn - 34) >> 2; off = WS_GATES + (size_t)g * M * D * 2; c0 = (pn - 34) & 3; mode = 2; }
        bf16* dst = (bf16*)(ws + off) + c0 * 256 + wc * 32 + 8 * fq;
#pragma unroll
        for (int ai = 0; ai < 2; ++ai)
#pragma unroll
            for (int m = 0; m < 4; ++m) {
                bf16* rowp = dst + (size_t)(row0 + ai * 128 + m * 16) * ldc;
#pragma unroll
                for (int bj = 0; bj < 2; ++bj) {
                    f32x4 v0 = acc[ai][bj][m][0], v1 = acc[ai][bj][m][1];
                    if (mode == 1) {
#pragma unroll
                        for (int j = 0; j < 4; ++j) { v0[j] = fsilu(v0[j]); v1[j] = fsilu(v1[j]); }
                    } else if (mode == 2) {
#pragma unroll
                        for (int j = 0; j < 4; ++j) { v0[j] = fsigmoid(v0[j]); v1[j] = fsigmoid(v1[j]); }
                    } else if (mode == 3) { v0 = v0 * 0.125f; v1 = v1 * 0.125f; }
                    *(v4u*)(rowp + bj * 128) = pack8(v0, v1);
                }
            }
    }
};
struct EpiMerge {
    static constexpr bool PERM = true, AFTER_DRAIN = false;
    const bf16* gates; float* macc; bf16* merged;
    __device__ __forceinline__ void operator()(const f32x4 (&acc)[2][2][4][2], const Unit& u, int wr, int wc, int fr, int fq) const {
        const int which = u.pn >> 2, pn = u.pn & 3, pm = u.pm & 63;
        const int row0 = pm * 256 + wr * 64 + fr, col0 = pn * 256 + wc * 32 + 8 * fq;
        const bf16* gp = gates + (size_t)which * M * D;
#pragma unroll
        for (int ai = 0; ai < 2; ++ai)
#pragma unroll
            for (int m = 0; m < 4; ++m) {
                const size_t ro = (size_t)(row0 + ai * 128 + m * 16) * D + col0;
#pragma unroll
                for (int bj = 0; bj < 2; ++bj) {
                    const size_t o = ro + bj * 128;
                    const v4u g = *(const v4u*)(gp + o);
                    f32x4 v0 = acc[ai][bj][m][0] * (f32x4){bflo(g.x), bfhi(g.x), bflo(g.y), bfhi(g.y)};
                    f32x4 v1 = acc[ai][bj][m][1] * (f32x4){bflo(g.z), bfhi(g.z), bflo(g.w), bfhi(g.w)};
                    float* mp = macc + o;
                    if (which != 0) { v0 += *(const f32x4*)mp; v1 += *(const f32x4*)(mp + 4); }
                    if (which != 2) { *(f32x4*)mp = v0; *(f32x4*)(mp + 4) = v1; }
                    else *(v4u*)(merged + o) = pack8(v0, v1);
                }
            }
    }
};
struct EpiResid {
    static constexpr bool PERM = true, AFTER_DRAIN = false;
    float* P; float* Q;
    __device__ __forceinline__ void operator()(const f32x4 (&acc)[2][2][4][2], const Unit& u, int wr, int wc, int fr, int fq) const {
        const int row0 = u.pm * 256 + wr * 64 + fr, col0 = u.pn * 256 + wc * 32 + 8 * fq;
#pragma unroll
        for (int ai = 0; ai < 2; ++ai)
#pragma unroll
            for (int m = 0; m < 4; ++m) {
                const size_t ro = (size_t)(row0 + ai * 128 + m * 16) * D + col0;
#pragma unroll
                for (int bj = 0; bj < 2; ++bj) {
                    const float* p = P + ro + bj * 128; float* q = Q + ro + bj * 128;
                    const f32x4 a = *(const f32x4*)p, b = *(const f32x4*)(p + 4);
                    *(f32x4*)q = a * DN_ALPHA + acc[ai][bj][m][0]; *(f32x4*)(q + 4) = b * DN_ALPHA + acc[ai][bj][m][1];
                }
            }
    }
};
struct EpiSwiglu {
    static constexpr bool PERM = true, AFTER_DRAIN = false;
    bf16* H; int ldh, nN;
    __device__ __forceinline__ void operator()(const f32x4 (&acc)[2][2][4][2], const Unit& u, int wr, int wc, int fr, int fq) const {
        const int n = u.pn % nN; const int row0 = u.pm * 256 + wr * 64 + fr, col0 = n * 128 + wc * 32 + 8 * fq;
#pragma unroll
        for (int ai = 0; ai < 2; ++ai)
#pragma unroll
            for (int m = 0; m < 4; ++m) {
                f32x4 v0 = acc[ai][0][m][0], v1 = acc[ai][0][m][1];
#pragma unroll
                for (int j = 0; j < 4; ++j) { v0[j] = fsilu(v0[j]); v1[j] = fsilu(v1[j]); }
                v0 = v0 * acc[ai][1][m][0]; v1 = v1 * acc[ai][1][m][1];
                *(v4u*)(H + (size_t)(row0 + ai * 128 + m * 16) * ldh + col0) = pack8(v0, v1);
            }
    }
};
struct EpiMoeDown {
    static constexpr bool PERM = true, AFTER_DRAIN = false;
    bf16* YS; const int* rowslot; const float* roww;
    __device__ __forceinline__ void operator()(const f32x4 (&acc)[2][2][4][2], const Unit& u, int wr, int wc, int fr, int fq) const {
        const int n = u.pn & 3; const int row0 = u.pm * 256 + wr * 64 + fr, col0 = n * 256 + wc * 32 + 8 * fq;
#pragma unroll
        for (int ai = 0; ai < 2; ++ai)
#pragma unroll
            for (int m = 0; m < 4; ++m) {
                const int r = row0 + ai * 128 + m * 16; const int slot = rowslot[r]; const float w = roww[r];
                if (slot >= 0) {
                    bf16* rp = YS + (size_t)slot * D + col0;
#pragma unroll
                    for (int bj = 0; bj < 2; ++bj) *(v4u*)(rp + bj * 128) = pack8(acc[ai][bj][m][0] * w, acc[ai][bj][m][1] * w);
                }
            }
    }
};
struct MergeOrder {
    pg8::StaticOrder S;
    __device__ bool next(int i, Unit& u) const { const int rnd = i / 3, which = i - 3 * rnd; if (!S.next(rnd, u)) return false; u.pm += which * 64; u.pn += which * 4; return true; }
    __device__ __forceinline__ void a_ready(const Unit&) const {}
    __device__ __forceinline__ void done(const Unit&) const {}
};
struct MoeOrder {
    pg8::StaticOrder S; int pend[NEXP]; int nN;
    __device__ void init(const unsigned* cnt, int nN_, int G, int c) {
        int p = 0;
#pragma unroll
        for (int e = 0; e < NEXP; ++e) { p += ((int)cnt[64 * e] + 255) >> 8; pend[e] = p; }
        nN = nN_; S.init(p * 256, nN_ * 256, G, c);
    }
    __device__ bool next(int i, Unit& u) const {
        if (!S.next(i, u)) return false;
        int e = 0;
#pragma unroll
        for (int k = 0; k < NEXP - 1; ++k) e += (u.pm >= pend[k]) ? 1 : 0;
        u.pn += e * nN; return true;
    }
    __device__ __forceinline__ void a_ready(const Unit&) const {}
    __device__ __forceinline__ void done(const Unit&) const {}
};
__device__ __forceinline__ void transpose_item(const float* W, int ldn, int k0, int n0, bf16* WT, int K, int drow0, int lane) {
    const int n4 = lane & 15, kq = lane >> 4;
    const float* src = W + (size_t)(k0 + 16 * kq) * ldn + n0 + 4 * n4;
    f32x4 v[16];
#pragma unroll
    for (int i = 0; i < 16; ++i) v[i] = __builtin_nontemporal_load((const f32x4*)(src + (size_t)i * ldn));
#pragma unroll
    for (int c = 0; c < 4; ++c) {
        bf16* dst = WT + (size_t)(drow0 + 4 * n4 + c) * K + k0 + 16 * kq;
        v4u o0, o1;
        o0.x = pkbf(v[0][c], v[1][c]); o0.y = pkbf(v[2][c], v[3][c]); o0.z = pkbf(v[4][c], v[5][c]); o0.w = pkbf(v[6][c], v[7][c]);
        o1.x = pkbf(v[8][c], v[9][c]); o1.y = pkbf(v[10][c], v[11][c]); o1.z = pkbf(v[12][c], v[13][c]); o1.w = pkbf(v[14][c], v[15][c]);
        *(v4u*)dst = o0; *(v4u*)(dst + 8) = o1;
    }
}
__device__ __forceinline__ int win_row(int s) {
#if MIX_HGRN_MFMA
    if (s >= 3072 && s < 5120) { const int z = s >= 4096, hd = ((s - 3072) & 1023) >> 7; return (12 + hd) * 256 + z * 128 + (s & 127); }
#endif
    if (s >= 1024) return s;
    const int which = s >> 9, head = (s & 511) >> 7, d = s & 127, bj = d >> 6, dd = d & 63;
    return (which * 2 + (head >> 1)) * 256 + bj * 128 + (head & 1) * 64 + dd;
}
__device__ __forceinline__ int gu_row(int s, int up) { return 256 * (s >> 7) + (s & 127) + (up ? 128 : 0); }

__device__ __forceinline__ const float* INP(int i) {
    const float* const* p = (const float* const*)__builtin_amdgcn_kernarg_segment_ptr();
    asm volatile("" : "+s"(p));
    return p[i];
}
__device__ __forceinline__ unsigned char* WSP() {
    unsigned char* const* p = (unsigned char* const*)__builtin_amdgcn_kernarg_segment_ptr();
    asm volatile("" : "+s"(p));
    return p[23];
}
struct Args { const float* in[22]; float* out; unsigned char* ws; int ph_lo, ph_hi; };
typedef Args Ptrs;

__device__ __forceinline__ void prologue_convert(int gw, int NGW, int lane) {
    constexpr int I_WIN = (D / 64) * (NIN / 64);
    constexpr int I_SQ = (D / 64) * (D / 64);
    constexpr int I_F = (D / 64) * (DFF / 64);
    constexpr int NITEMS = 2 * I_WIN + 8 * I_SQ + 3 * I_F;
    unsigned char* ws = WSP();
    for (int it = gw; it < NITEMS; it += NGW) {
        int r = it;
        if (r < 2 * I_WIN) { const int l = r / I_WIN; r -= l * I_WIN; const int nblk = NIN / 64, kb = r / nblk, nb = r % nblk;
            transpose_item(INP(3) + (size_t)l * D * NIN, NIN, 64 * kb, 64 * nb, (bf16*)(ws + WS_WIN) + (size_t)l * NIN * D, D, win_row(64 * nb), lane); continue; }
        r -= 2 * I_WIN;
        if (r < 8 * I_SQ) { const int mi = r / I_SQ; r -= mi * I_SQ; const int l = mi >> 2, w = mi & 3;
            const float* src = (w == 0 ? INP(4) : w == 1 ? INP(7) : w == 2 ? INP(9) : INP(10)) + (size_t)l * D * D;
            bf16* dst = (bf16*)(ws + WS_WOUT + (size_t)l * 8 * MiB) + (size_t)w * D * D;
            const int kb = r / 16, nb = r % 16; transpose_item(src, D, 64 * kb, 64 * nb, dst, D, 64 * nb, lane); continue; }
        r -= 8 * I_SQ;
        if (r < 2 * I_F) { const int up = r / I_F; r -= up * I_F; const int nblk = DFF / 64, kb = r / nblk, nb = r % nblk;
            transpose_item(up ? INP(14) : INP(13), DFF, 64 * kb, 64 * nb, (bf16*)(ws + WS_WGU), D, gu_row(64 * nb, up), lane); continue; }
        r -= 2 * I_F;
        { const int kb = r / 16, nb = r % 16; transpose_item(INP(15), D, 64 * kb, 64 * nb, (bf16*)(ws + WS_WDN), DFF, 64 * nb, lane); }
    }
}
__device__ __forceinline__ void moe_convert(int gw, int NGW, int lane) {
    constexpr int I_E = (D / 64) * (DEXP / 64);
    unsigned char* ws = WSP();
    for (int it = gw; it < 24 * I_E; it += NGW) {
        const int mi = it / I_E, r = it - mi * I_E, kind = mi >> 3, e = mi & 7;
        if (kind < 2) { const int nblk = DEXP / 64, kb = r / nblk, nb = r % nblk;
            transpose_item((kind ? INP(18) : INP(17)) + (size_t)e * D * DEXP, DEXP, 64 * kb, 64 * nb, (bf16*)(ws + WS_WGUE) + (size_t)e * 2 * DEXP * D, D, gu_row(64 * nb, kind), lane); }
        else { const int kb = r / 16, nb = r % 16;
            transpose_item(INP(19) + (size_t)e * DEXP * D, D, 64 * kb, 64 * nb, (bf16*)(ws + WS_WDNE) + (size_t)e * D * DEXP, DEXP, 64 * nb, lane); }
    }
}
__device__ __forceinline__ void ln_core(f32x4 (&v)[4], const float* g, const float* b, int lane) {
    float s = 0.f;
#pragma unroll
    for (int j = 0; j < 4; ++j) s += (v[j][0] + v[j][1]) + (v[j][2] + v[j][3]);
    const float mean = wave_sum(s) * (1.f / D); float s2 = 0.f;
#pragma unroll
    for (int j = 0; j < 4; ++j) { v[j] = v[j] - mean; s2 += (v[j][0] * v[j][0] + v[j][1] * v[j][1]) + (v[j][2] * v[j][2] + v[j][3] * v[j][3]); }
    const float rstd = 1.f / sqrtf(wave_sum(s2) * (1.f / D) + LN_EPS);
#pragma unroll
    for (int j = 0; j < 4; ++j) { const f32x4 gg = *(const f32x4*)(g + 4 * lane + 256 * j), bb = *(const f32x4*)(b + 4 * lane + 256 * j); v[j] = v[j] * rstd * gg + bb; }
}
__device__ __forceinline__ void store_row_f32(float* dst, const f32x4 (&v)[4], int lane) {
#pragma unroll
    for (int j = 0; j < 4; ++j) *(f32x4*)(dst + 4 * lane + 256 * j) = v[j];
}
__device__ __forceinline__ void store_row_bf16(bf16* dst, const f32x4 (&v)[4], int lane) {
#pragma unroll
    for (int j = 0; j < 4; ++j) { v2u w; w.x = pk2(v[j][0], v[j][1]); w.y = pk2(v[j][2], v[j][3]); *(v2u*)(dst + 4 * lane + 256 * j) = w; }
}
__device__ __forceinline__ void ret_seq(unsigned char* ws, int item, LAS float* sm, int tid) {
    const int b = item >> 2, h = item & 3, dv = tid & 255, kh = tid >> 8, wave = tid >> 6, lane = tid & 63;
    const float gamma = 1.f - exp2f(-5.f - (float)h);
    const bf16* RQ = (const bf16*)(ws + WS_RQ); const bf16* RK = (const bf16*)(ws + WS_RK); const bf16* RV = (const bf16*)(ws + WS_RV); bf16* RG = (bf16*)(ws + WS_OABC);
    LAS float* qs = sm; LAS float* ks = sm + 2048; LAS float* part = sm + 4096;
    float S[64];
#pragma unroll
    for (int i = 0; i < 64; ++i) S[i] = 0.f;
    for (int c0 = 0; c0 < SEQ; c0 += 16) {
        const size_t row0 = (size_t)b * SEQ + c0;
        for (int i = tid; i < 2048; i += 512) { const int t = i >> 7, d = i & 127; qs[i] = bf2f(RQ[(row0 + t) * 512 + h * 128 + d]); ks[i] = bf2f(RK[(row0 + t) * 512 + h * 128 + d]) * exp2f((float)((c0 + t) & 63) * log2f(gamma)); }
        __syncthreads();
        for (int t = 0; t < 16; ++t) {
            const float v = bf2f(RV[(row0 + t) * 1024 + h * 256 + dv]); float po = 0.f;
            const LAS float* kp = ks + t * 128 + kh * 64; const LAS float* qp = qs + t * 128 + kh * 64;
#pragma unroll
            for (int i = 0; i < 64; ++i) { S[i] = gamma * S[i] + kp[i] * v; po += qp[i] * S[i]; }
            part[(t * 2 + kh) * 256 + dv] = po;
        }
        __syncthreads();
#pragma unroll
        for (int tt = 0; tt < 2; ++tt) {
            const int t = 2 * wave + tt; float o[4]; float ss = 0.f;
#pragma unroll
            for (int j = 0; j < 4; ++j) { o[j] = part[(t * 2) * 256 + lane * 4 + j] + part[(t * 2 + 1) * 256 + lane * 4 + j]; ss += o[j] * o[j]; }
            const float rstd = 1.f / sqrtf(wave_sum(ss) * (1.f / 256.f) + RMS_EPS);
            bf16* gp = RG + (row0 + t) * 1024 + h * 256 + lane * 4; const v2u g = *(const v2u*)gp;
            v2u w; w.x = pk2(o[0] * rstd * bflo(g.x), o[1] * rstd * bfhi(g.x)); w.y = pk2(o[2] * rstd * bflo(g.y), o[3] * rstd * bfhi(g.y));
            *(v2u*)gp = w;
        }
        __syncthreads();
    }
}
__device__ __forceinline__ void hgrn_seq(unsigned char* ws, const float* lb, const float* ng, int item, LAS float* sm, int tid) {
    const int b = item >> 3, h = item & 7, dv = tid & 127, kq = tid >> 7, wave = tid >> 6, lane = tid & 63;
    const bf16* HQ = (const bf16*)(ws + WS_HQ); const bf16* HF = (const bf16*)(ws + WS_HF); const bf16* HI = (const bf16*)(ws + WS_HI); bf16* HG = (bf16*)(ws + WS_OABC) + (size_t)M * D;
    LAS float* fs = sm; LAS float* qs = sm + 2048; LAS float* part = sm + 4096;
    float S[32];
#pragma unroll
    for (int i = 0; i < 32; ++i) S[i] = 0.f;
    for (int c0 = 0; c0 < SEQ; c0 += 16) {
        const size_t row0 = (size_t)b * SEQ + c0;
        for (int i = tid; i < 2048; i += 512) { const int t = i >> 7, d = i & 127; const float z = bf2f(HF[(row0 + t) * 1024 + h * 128 + d]); const float l = lb ? lb[h * 128 + d] : 0.f;
            fs[i] = l + (1.f - l) * fsigmoid(z); qs[i] = bf2f(HQ[(row0 + t) * 1024 + h * 128 + d]); }
        __syncthreads();
        for (int t = 0; t < 16; ++t) {
            const float v = bf2f(HI[(row0 + t) * 1024 + h * 128 + dv]); float po = 0.f;
            const LAS float* fp = fs + t * 128 + kq * 32; const LAS float* qp = qs + t * 128 + kq * 32;
#pragma unroll
            for (int i = 0; i < 32; ++i) { const float f = fp[i]; S[i] = f * S[i] + (1.f - f) * v; po += qp[i] * S[i]; }
            part[(t * 4 + kq) * 128 + dv] = po;
        }
        __syncthreads();
#pragma unroll
        for (int tt = 0; tt < 2; ++tt) {
            const int t = 2 * wave + tt; float o[2]; float ss = 0.f;
#pragma unroll
            for (int j = 0; j < 2; ++j) { const int c = lane * 2 + j; o[j] = (part[(t * 4) * 128 + c] + part[(t * 4 + 1) * 128 + c]) + (part[(t * 4 + 2) * 128 + c] + part[(t * 4 + 3) * 128 + c]); ss += o[j] * o[j]; }
            const float rstd = 1.f / sqrtf(wave_sum(ss) * (1.f / 128.f) + RMS_EPS);
            bf16* gp = HG + (row0 + t) * 1024 + h * 128 + lane * 2; const unsigned g = *(const unsigned*)gp;
            *(unsigned*)gp = pk2(o[0] * rstd * ng[lane * 2] * bflo(g), o[1] * rstd * ng[lane * 2 + 1] * bfhi(g));
        }
        __syncthreads();
    }
}
__device__ __forceinline__ void swa_seq(unsigned char* ws, const float* sinks, int item, int lane) {
    const int hq = item & 15, c = (item >> 4) & 31, b = item >> 9, kvh = hq >> 2;
    bf16* SQ = (bf16*)(ws + WS_OABC) + (size_t)2 * M * D; const bf16* SK = (const bf16*)(ws + WS_SK); const bf16* SV = (const bf16*)(ws + WS_SV);
    bf16* qp = SQ + ((size_t)b * SEQ + c * 64 + lane) * 1024 + hq * 64;
    float q[64], o[64];
#pragma unroll
    for (int i = 0; i < 8; ++i) { const v4u w = *(const v4u*)(qp + 8 * i);
        q[8 * i] = bflo(w.x); q[8 * i + 1] = bfhi(w.x); q[8 * i + 2] = bflo(w.y); q[8 * i + 3] = bfhi(w.y); q[8 * i + 4] = bflo(w.z); q[8 * i + 5] = bfhi(w.z); q[8 * i + 6] = bflo(w.w); q[8 * i + 7] = bfhi(w.w); }
#pragma unroll
    for (int i = 0; i < 64; ++i) o[i] = 0.f;
    float mx = sinks[hq], l = 1.f;
    const int s0 = (c >= 2 ? c - 2 : 0) * 64, s1 = c * 64 + 64;
    for (int s = s0; s < s1; ++s) {
        const bf16* kp = SK + ((size_t)b * SEQ + s) * 256 + kvh * 64; const bf16* vp = SV + ((size_t)b * SEQ + s) * 256 + kvh * 64;
        float sc = 0.f;
#pragma unroll
        for (int i = 0; i < 8; ++i) { const v4u w = *(const v4u*)(kp + 8 * i);
            sc += q[8 * i] * bflo(w.x) + q[8 * i + 1] * bfhi(w.x) + q[8 * i + 2] * bflo(w.y) + q[8 * i + 3] * bfhi(w.y) + q[8 * i + 4] * bflo(w.z) + q[8 * i + 5] * bfhi(w.z) + q[8 * i + 6] * bflo(w.w) + q[8 * i + 7] * bfhi(w.w); }
        const float mn = fmaxf(mx, sc), a = __expf(mx - mn), p = __expf(sc - mn); mx = mn; l = l * a + p;
#pragma unroll
        for (int i = 0; i < 8; ++i) { const v4u w = *(const v4u*)(vp + 8 * i);
            o[8 * i] = o[8 * i] * a + p * bflo(w.x); o[8 * i + 1] = o[8 * i + 1] * a + p * bfhi(w.x); o[8 * i + 2] = o[8 * i + 2] * a + p * bflo(w.y); o[8 * i + 3] = o[8 * i + 3] * a + p * bfhi(w.y);
            o[8 * i + 4] = o[8 * i + 4] * a + p * bflo(w.z); o[8 * i + 5] = o[8 * i + 5] * a + p * bfhi(w.z); o[8 * i + 6] = o[8 * i + 6] * a + p * bflo(w.w); o[8 * i + 7] = o[8 * i + 7] * a + p * bfhi(w.w); }
    }
    const float inv = 1.f / l;
#pragma unroll
    for (int i = 0; i < 8; ++i) { v4u w; w.x = pk2(o[8 * i] * inv, o[8 * i + 1] * inv); w.y = pk2(o[8 * i + 2] * inv, o[8 * i + 3] * inv); w.z = pk2(o[8 * i + 4] * inv, o[8 * i + 5] * inv); w.w = pk2(o[8 * i + 6] * inv, o[8 * i + 7] * inv);
        *(v4u*)(qp + 8 * i) = w; }
}
typedef float f32x16 __attribute__((ext_vector_type(16)));
typedef short bf16x8 __attribute__((ext_vector_type(8)));
typedef short s16x4 __attribute__((ext_vector_type(4)));
#define MFMA32(a, b, c) __builtin_amdgcn_mfma_f32_32x32x16_bf16((a), (b), (c), 0, 0, 0)
#define MFMA16(a, b, c) __builtin_amdgcn_mfma_f32_16x16x32_bf16((a), (b), (c), 0, 0, 0)
#define MFMA16K16(a, b, c) __builtin_amdgcn_mfma_f32_16x16x16bf16_1k((a), (b), (c), 0, 0, 0)
__device__ __forceinline__ s16x4 lds_tr4(LAS unsigned char* p) { return __builtin_amdgcn_ds_read_tr16_b64_v4i16((LAS s16x4*)p); }
__device__ __forceinline__ bf16x8 cat8(s16x4 a, s16x4 b) { return (bf16x8){a[0], a[1], a[2], a[3], b[0], b[1], b[2], b[3]}; }
__device__ __forceinline__ bf16x8 pack8r(const f32x16& x, int s8) {
    v4u p; p.x = pkbf(x[s8], x[s8 + 1]); p.y = pkbf(x[s8 + 2], x[s8 + 3]); p.z = pkbf(x[s8 + 4], x[s8 + 5]); p.w = pkbf(x[s8 + 6], x[s8 + 7]); return __builtin_bit_cast(bf16x8, p);
}
#define LDS_BARRIER() asm volatile("s_waitcnt lgkmcnt(0)\n\ts_barrier" ::: "memory")
constexpr int SWA_KP = 144, SWA_VP = 192, SWA_VOFF = 192 * SWA_KP;
__device__ __forceinline__ void swa_unit(unsigned char* ws, const float* sinks, int unit, LAS unsigned char* sm, long odelta) {
    int tid_ = threadIdx.x; asm volatile("" : "+v"(tid_));
    const int tid = tid_, lane = tid & 63, wave = __builtin_amdgcn_readfirstlane(tid >> 6), h = lane >> 5, r31 = lane & 31;
    const int kvh = unit & 3, c = (unit >> 2) & 31, b = unit >> 7;
    const int nch = c < 2 ? c + 1 : 3, nk = nch * 64, s0 = (c + 1 - nch) * 64;
    bf16* SQ = (bf16*)(ws + WS_OABC) + (size_t)2 * M * D; const bf16* SK = (const bf16*)(ws + WS_SK); const bf16* SV = (const bf16*)(ws + WS_SV);
    for (int idx = tid; idx < nk * 8; idx += 512) {
        const int row = idx >> 3, ch = idx & 7; const size_t g = ((size_t)b * SEQ + s0 + row) * 256 + kvh * 64 + ch * 8;
        const v4u kv = *(const v4u*)(SK + g), vv = *(const v4u*)(SV + g);
        *(LAS v4u*)(sm + row * SWA_KP + ch * 16) = kv; *(LAS v4u*)(sm + SWA_VOFF + row * SWA_VP + ch * 16) = vv;
    }
    const int hq = kvh * 4 + (wave >> 1);
    bf16* qp = SQ + ((size_t)b * SEQ + c * 64 + (wave & 1) * 32 + r31) * 1024 + hq * 64;
    bf16x8 bq[4];
#pragma unroll
    for (int ks = 0; ks < 4; ++ks) bq[ks] = *(const bf16x8*)(qp + 16 * ks + 8 * h);
    const float sink = sinks[hq];
    LDS_BARRIER();
    f32x16 st[6];
#pragma unroll
    for (int kt = 0; kt < 6; ++kt) {
        if (kt < 2 * nch) {
            f32x16 a = {0.f, 0.f, 0.f, 0.f, 0.f, 0.f, 0.f, 0.f, 0.f, 0.f, 0.f, 0.f, 0.f, 0.f, 0.f, 0.f};
#pragma unroll
            for (int ks = 0; ks < 4; ++ks) { const bf16x8 kf = *(const LAS bf16x8*)(sm + (32 * kt + r31) * SWA_KP + (16 * ks + 8 * h) * 2); a = MFMA32(kf, bq[ks], a); }
            st[kt] = a;
        } else {
#pragma unroll
            for (int r = 0; r < 16; ++r) st[kt][r] = -1.0e30f;
        }
    }
    float mx = sink;
#pragma unroll
    for (int kt = 0; kt < 6; ++kt)
#pragma unroll
        for (int r = 0; r < 16; ++r) mx = fmaxf(mx, st[kt][r]);
    mx = fmaxf(mx, __shfl_xor(mx, 32));
    float l = 0.f;
#pragma unroll
    for (int kt = 0; kt < 6; ++kt)
#pragma unroll
        for (int r = 0; r < 16; ++r) { const float p = __expf(st[kt][r] - mx); st[kt][r] = p; l += p; }
    l += __shfl_xor(l, 32); l += __expf(sink - mx);
    f32x16 o[2];
#pragma unroll
    for (int dt = 0; dt < 2; ++dt)
#pragma unroll
        for (int r = 0; r < 16; ++r) o[dt][r] = 0.f;
    LAS unsigned char* vbase = sm + SWA_VOFF + (4 * h + ((lane & 15) >> 2)) * SWA_VP + (16 * ((lane >> 4) & 1) + 4 * (lane & 3)) * 2;
#pragma unroll
    for (int kt = 0; kt < 6; ++kt) {
        if (kt < 2 * nch) {
#pragma unroll
            for (int s = 0; s < 2; ++s) {
                const bf16x8 pb = pack8r(st[kt], 8 * s);
#pragma unroll
                for (int dt = 0; dt < 2; ++dt) {
                    LAS unsigned char* vp = vbase + (32 * kt + 16 * s) * SWA_VP + 64 * dt;
                    const bf16x8 vf = cat8(lds_tr4(vp), lds_tr4(vp + 8 * SWA_VP));
                    o[dt] = MFMA32(vf, pb, o[dt]);
                }
            }
        }
    }
    const float inv = 1.f / l;
#pragma unroll
    for (int dt = 0; dt < 2; ++dt)
#pragma unroll
        for (int rg = 0; rg < 4; ++rg) {
            v2u w; w.x = pkbf(o[dt][4 * rg] * inv, o[dt][4 * rg + 1] * inv); w.y = pkbf(o[dt][4 * rg + 2] * inv, o[dt][4 * rg + 3] * inv);
            *(v2u*)(qp + odelta + 32 * dt + 8 * rg + 4 * h) = w;
        }
    LDS_BARRIER();
}
constexpr int RT_QP = 272, RT_VP = 576, RT_PP = 144;
constexpr int RT_QOFF = 0, RT_KOFF = 64 * RT_QP, RT_VOFF = 2 * 64 * RT_QP, RT_POFF = RT_VOFF + 64 * RT_VP, RT_SOFF = RT_POFF + 64 * RT_PP;
__device__ __forceinline__ void ret_unit(unsigned char* ws, int item, LAS unsigned char* sm, long odelta) {
    int tid_ = threadIdx.x; asm volatile("" : "+v"(tid_));
    const int tid = tid_, lane = tid & 63, w = __builtin_amdgcn_readfirstlane(tid >> 6), h = lane >> 5, r31 = lane & 31, g4 = lane >> 4, c15 = lane & 15, blk = (lane >> 4) & 1, p3 = lane & 3;
    const int b = item >> 2, hd = item & 3;
    const float lg = log2f(1.f - exp2f(-5.f - (float)hd)), g64 = exp2f(64.f * lg);
    const bf16* RQ = (const bf16*)(ws + WS_RQ); const bf16* RK = (const bf16*)(ws + WS_RK); const bf16* RV = (const bf16*)(ws + WS_RV); bf16* RG = (bf16*)(ws + WS_OABC);
    LAS float* part = (LAS float*)(sm + RT_SOFF);
    v4u pq[2], pk[2], pv[4]; v2u gq[2][4], gcur[2][4];
    const int qrow = tid >> 4, qch = tid & 15, vrow = tid >> 5, vch = tid & 31;
#define RT_LOAD(n_) do { const size_t r0_ = (size_t)b * SEQ + 64 * (n_); \
        _Pragma("unroll") for (int j = 0; j < 2; ++j) { pq[j] = *(const v4u*)(RQ + (r0_ + qrow + 32 * j) * 512 + hd * 128 + qch * 8); pk[j] = *(const v4u*)(RK + (r0_ + qrow + 32 * j) * 512 + hd * 128 + qch * 8); } \
        _Pragma("unroll") for (int j = 0; j < 4; ++j) pv[j] = *(const v4u*)(RV + (r0_ + vrow + 16 * j) * 1024 + hd * 256 + vch * 8); \
        _Pragma("unroll") for (int tt = 0; tt < 2; ++tt) _Pragma("unroll") for (int rg = 0; rg < 4; ++rg) gq[tt][rg] = *(const v2u*)(RG + (r0_ + 32 * tt + r31) * 1024 + hd * 256 + 32 * w + 4 * h + 8 * rg); } while (0)
#define RT_STORE() do { \
        _Pragma("unroll") for (int j = 0; j < 2; ++j) { *(LAS v4u*)(sm + RT_QOFF + (qrow + 32 * j) * RT_QP + qch * 16) = pq[j]; *(LAS v4u*)(sm + RT_KOFF + (qrow + 32 * j) * RT_QP + qch * 16) = pk[j]; } \
        _Pragma("unroll") for (int j = 0; j < 4; ++j) *(LAS v4u*)(sm + RT_VOFF + (vrow + 16 * j) * RT_VP + vch * 16) = pv[j]; } while (0)
    RT_LOAD(0); RT_STORE();
    if (tid < 64) { const int tile = tid >> 5, rr = (tid >> 1) & 15, cc = tid & 1;
        *(LAS v4u*)(sm + RT_POFF + (32 * tile + rr) * RT_PP + (16 + 32 * tile + 8 * cc) * 2) = (v4u){0u, 0u, 0u, 0u}; }
    f32x16 sp[4];
#pragma unroll
    for (int i = 0; i < 4; ++i)
#pragma unroll
        for (int r = 0; r < 16; ++r) sp[i][r] = 0.f;
    LDS_BARRIER();
    for (int n = 0; n < 32; ++n) {
        const size_t row0 = (size_t)b * SEQ + 64 * n;
#pragma unroll
        for (int tt = 0; tt < 2; ++tt)
#pragma unroll
            for (int rg = 0; rg < 4; ++rg) gcur[tt][rg] = gq[tt][rg];
        if (n + 1 < 32) RT_LOAD(n + 1);
        for (int tile = w; tile < 10; tile += 8) {
            const int tb = tile < 1 ? 0 : tile < 3 ? 1 : tile < 6 ? 2 : 3, sb = tile - (tb * (tb + 1)) / 2;
            bf16x8 kf[4], qf[4];
#pragma unroll
            for (int st = 0; st < 4; ++st) {
                kf[st] = *(const LAS bf16x8*)(sm + RT_KOFF + (16 * sb + c15) * RT_QP + (32 * st + 8 * g4) * 2);
                qf[st] = *(const LAS bf16x8*)(sm + RT_QOFF + (16 * tb + c15) * RT_QP + (32 * st + 8 * g4) * 2);
            }
            f32x4 a0 = {0.f, 0.f, 0.f, 0.f}, a1 = {0.f, 0.f, 0.f, 0.f};
            a0 = MFMA16(kf[0], qf[0], a0); a1 = MFMA16(kf[1], qf[1], a1); a0 = MFMA16(kf[2], qf[2], a0); a1 = MFMA16(kf[3], qf[3], a1);
            f32x4 a = a0 + a1;
            if (tb == sb) {
#pragma unroll
                for (int r = 0; r < 4; ++r) if (4 * g4 + r > c15) a[r] = 0.f;
            }
            v2u pw; pw.x = pkbf(a[0], a[1]); pw.y = pkbf(a[2], a[3]);
            *(LAS v2u*)(sm + RT_POFF + (16 * tb + c15) * RT_PP + (16 * sb + 4 * g4) * 2) = pw;
        }
        LDS_BARRIER();
        f32x16 oa[2];
#pragma unroll
        for (int tt = 0; tt < 2; ++tt)
#pragma unroll
            for (int r = 0; r < 16; ++r) oa[tt][r] = 0.f;
        bf16x8 vf[4];
#pragma unroll
        for (int ss = 0; ss < 4; ++ss) { LAS unsigned char* vp = sm + RT_VOFF + (16 * ss + 8 * h + (c15 >> 2)) * RT_VP + (32 * w + 16 * blk + 4 * p3) * 2; vf[ss] = cat8(lds_tr4(vp), lds_tr4(vp + 4 * RT_VP)); }
        bf16x8 pf[6];
#pragma unroll
        for (int i = 0; i < 6; ++i) { const int tt = i < 2 ? 0 : 1, ss = i < 2 ? i : i - 2; pf[i] = *(const LAS bf16x8*)(sm + RT_POFF + (32 * tt + r31) * RT_PP + (16 * ss + 8 * h) * 2); }
#pragma unroll
        for (int dp = 0; dp < 2; ++dp) {
            v2u qa[2][2][2], qb[2][2][2];
#pragma unroll
            for (int d2 = 0; d2 < 2; ++d2)
#pragma unroll
                for (int s2 = 0; s2 < 2; ++s2)
#pragma unroll
                    for (int tt = 0; tt < 2; ++tt) {
                        const LAS unsigned char* qp = sm + RT_QOFF + (32 * tt + r31) * RT_QP + (32 * (2 * dp + d2) + 16 * s2 + 4 * h) * 2;
                        qa[d2][s2][tt] = *(const LAS v2u*)qp; qb[d2][s2][tt] = *(const LAS v2u*)(qp + 16);
                    }
#pragma unroll
            for (int d2 = 0; d2 < 2; ++d2)
#pragma unroll
                for (int s2 = 0; s2 < 2; ++s2) {
                    const bf16x8 af = pack8r(sp[2 * dp + d2], 8 * s2);
#pragma unroll
                    for (int tt = 0; tt < 2; ++tt)
                        oa[tt] = MFMA32(af, __builtin_bit_cast(bf16x8, ((v4u){qa[d2][s2][tt].x, qa[d2][s2][tt].y, qb[d2][s2][tt].x, qb[d2][s2][tt].y})), oa[tt]);
                }
        }
#pragma unroll
        for (int i = 0; i < 6; ++i) { const int tt = i < 2 ? 0 : 1, ss = i < 2 ? i : i - 2; oa[tt] = MFMA32(vf[ss], pf[i], oa[tt]); }
#pragma unroll
        for (int dkt = 0; dkt < 4; ++dkt) {
            bf16x8 kt[4];
#pragma unroll
            for (int ss = 0; ss < 4; ++ss) { LAS unsigned char* kp = sm + RT_KOFF + (16 * ss + 8 * h + (c15 >> 2)) * RT_QP + (32 * dkt + 16 * blk + 4 * p3) * 2; kt[ss] = cat8(lds_tr4(kp), lds_tr4(kp + 4 * RT_QP)); }
#pragma unroll
            for (int ss = 0; ss < 4; ++ss) sp[dkt] = MFMA32(kt[ss], vf[ss], sp[dkt]);
#pragma unroll
            for (int r = 0; r < 16; ++r) sp[dkt][r] *= g64;
        }
#pragma unroll
        for (int tt = 0; tt < 2; ++tt) { float ss = 0.f;
#pragma unroll
            for (int r = 0; r < 16; ++r) ss += oa[tt][r] * oa[tt][r];
            ss += __shfl_xor(ss, 32); if (h == 0) part[(32 * tt + r31) * 8 + w] = ss; }
        LDS_BARRIER();
#pragma unroll
        for (int tt = 0; tt < 2; ++tt) {
            const int t = 32 * tt + r31; const f32x4 pa = *(const LAS f32x4*)(part + t * 8), pb2 = *(const LAS f32x4*)(part + t * 8 + 4);
            const float tot = ((pa[0] + pa[1]) + (pa[2] + pa[3])) + ((pb2[0] + pb2[1]) + (pb2[2] + pb2[3]));
            const float gt = exp2f((float)t * lg), scale = gt / sqrtf(tot * gt * gt * (1.f / 256.f) + RMS_EPS);
            bf16* gp = RG + (row0 + t) * 1024 + hd * 256 + 32 * w + 4 * h;
#pragma unroll
            for (int rg = 0; rg < 4; ++rg) { const v2u g = gcur[tt][rg];
                v2u o; o.x = pkbf(oa[tt][4 * rg] * scale * bflo(g.x), oa[tt][4 * rg + 1] * scale * bfhi(g.x)); o.y = pkbf(oa[tt][4 * rg + 2] * scale * bflo(g.y), oa[tt][4 * rg + 3] * scale * bfhi(g.y));
                *(v2u*)(gp + odelta + 8 * rg) = o; }
        }
        if (n + 1 < 32) RT_STORE();
        LDS_BARRIER();
    }
#undef RT_LOAD
#undef RT_STORE
}
constexpr int HG_QP = 272, HG_VP = 288;
constexpr int HG_QOFF = 0, HG_KOFF = 64 * HG_QP, HG_VOFF = 2 * 64 * HG_QP, HG_DOFF = HG_VOFF + 64 * HG_VP, HG_SOFF = HG_DOFF + 2048;
__device__ __forceinline__ void hgrn_unit(unsigned char* ws, const float* ng, int item, LAS unsigned char* sm, long odelta) {
    int tid_ = threadIdx.x; asm volatile("" : "+v"(tid_));
    const int tid = tid_, lane = tid & 63, w = __builtin_amdgcn_readfirstlane(tid >> 6), g4 = lane >> 4, c15 = lane & 15, p3 = lane & 3;
    const int b = item >> 3, hd = item & 7;
    const bf16* HQ = (const bf16*)(ws + WS_HQ); const bf16* HF = (const bf16*)(ws + WS_HF); const bf16* HI = (const bf16*)(ws + WS_HI); bf16* HG = (bf16*)(ws + WS_OABC) + (size_t)M * D;
    const float* DD = (const float*)(ws + WS_HD);
    LAS float* dimg = (LAS float*)(sm + HG_DOFF); LAS float* part = (LAS float*)(sm + HG_SOFF);
    v4u pq[2], pk[2], pv[2]; float pd; v2u gq[4], gcur[4];
    const int srow = tid >> 4, sch = tid & 15;
#define HG_LOAD(n_) do { const size_t r0_ = (size_t)b * SEQ + 64 * (n_); \
        _Pragma("unroll") for (int j = 0; j < 2; ++j) { const size_t o_ = (r0_ + srow + 32 * j) * 1024 + hd * 128 + sch * 8; pq[j] = *(const v4u*)(HQ + o_); pk[j] = *(const v4u*)(HF + o_); pv[j] = *(const v4u*)(HI + o_); } \
        pd = DD[(r0_ / 16 + (tid >> 7)) * 1024 + hd * 128 + (tid & 127)]; \
        _Pragma("unroll") for (int bk = 0; bk < 4; ++bk) gq[bk] = *(const v2u*)(HG + (r0_ + 16 * bk + c15) * 1024 + hd * 128 + 16 * w + 4 * g4); } while (0)
#define HG_STORE() do { \
        _Pragma("unroll") for (int j = 0; j < 2; ++j) { *(LAS v4u*)(sm + HG_QOFF + (srow + 32 * j) * HG_QP + sch * 16) = pq[j]; *(LAS v4u*)(sm + HG_KOFF + (srow + 32 * j) * HG_QP + sch * 16) = pk[j]; \
            *(LAS v4u*)(sm + HG_VOFF + (srow + 32 * j) * HG_VP + sch * 16) = pv[j]; } \
        dimg[tid] = pd; } while (0)
    HG_LOAD(0); HG_STORE();
    f32x4 sp[8];
#pragma unroll
    for (int i = 0; i < 8; ++i) sp[i] = (f32x4){0.f, 0.f, 0.f, 0.f};
    const f32x4 ngv = *(const f32x4*)(ng + 16 * w + 4 * g4);
    LDS_BARRIER();
    for (int n = 0; n < 32; ++n) {
        const size_t row0 = (size_t)b * SEQ + 64 * n;
#pragma unroll
        for (int bk = 0; bk < 4; ++bk) gcur[bk] = gq[bk];
        if (n + 1 < 32) HG_LOAD(n + 1);
        f32x4 og[4]; float psum[4];
        v2u atp[4]; s16x4 vfr4[4];
#pragma unroll
        for (int bk = 0; bk < 4; ++bk) vfr4[bk] = lds_tr4(sm + HG_VOFF + (16 * bk + 4 * g4 + (c15 >> 2)) * HG_VP + (16 * w + 4 * p3) * 2);
#pragma unroll
        for (int hb = 0; hb < 2; ++hb) {
            bf16x8 kf[2][4], qf[2][4];
#pragma unroll
            for (int b2 = 0; b2 < 2; ++b2)
#pragma unroll
                for (int st = 0; st < 4; ++st) {
                    kf[b2][st] = *(const LAS bf16x8*)(sm + HG_KOFF + (16 * (2 * hb + b2) + c15) * HG_QP + (32 * st + 8 * g4) * 2);
                    qf[b2][st] = *(const LAS bf16x8*)(sm + HG_QOFF + (16 * (2 * hb + b2) + c15) * HG_QP + (32 * st + 8 * g4) * 2);
                }
#pragma unroll
            for (int b2 = 0; b2 < 2; ++b2) {
                f32x4 a0 = {0.f, 0.f, 0.f, 0.f}, a1 = {0.f, 0.f, 0.f, 0.f};
                a0 = MFMA16(kf[b2][0], qf[b2][0], a0); a1 = MFMA16(kf[b2][1], qf[b2][1], a1); a0 = MFMA16(kf[b2][2], qf[b2][2], a0); a1 = MFMA16(kf[b2][3], qf[b2][3], a1);
                f32x4 at = a0 + a1;
#pragma unroll
                for (int r = 0; r < 4; ++r) if (4 * g4 + r > c15) at[r] = 0.f;
                atp[2 * hb + b2] = (v2u){pkbf(at[0], at[1]), pkbf(at[2], at[3])};
            }
        }
#pragma unroll
        for (int bk = 0; bk < 4; ++bk) {
            v2u q0[4], q1[4]; s16x4 kfr4[8]; f32x4 dvv[8];
#pragma unroll
            for (int I = 0; I < 4; ++I) { const LAS unsigned char* qp = sm + HG_QOFF + (16 * bk + c15) * HG_QP + (32 * I + 4 * g4) * 2; q0[I] = *(const LAS v2u*)qp; q1[I] = *(const LAS v2u*)(qp + 32); }
#pragma unroll
            for (int i = 0; i < 8; ++i) { kfr4[i] = lds_tr4(sm + HG_KOFF + (16 * bk + 4 * g4 + (c15 >> 2)) * HG_QP + (16 * i + 4 * p3) * 2); dvv[i] = *(const LAS f32x4*)(dimg + bk * 128 + 16 * i + 4 * g4); }
            const bf16x8 bfr = __builtin_bit_cast(bf16x8, ((v4u){atp[bk].x, atp[bk].y, 0u, 0u}));
            const bf16x8 vfr = (bf16x8){vfr4[bk][0], vfr4[bk][1], vfr4[bk][2], vfr4[bk][3], 0, 0, 0, 0};
            f32x4 o = {0.f, 0.f, 0.f, 0.f};
            o = MFMA16(vfr, bfr, o);
#pragma unroll
            for (int I = 0; I < 4; ++I) {
                const v4u ap = (v4u){pkbf(sp[2 * I][0], sp[2 * I][1]), pkbf(sp[2 * I][2], sp[2 * I][3]), pkbf(sp[2 * I + 1][0], sp[2 * I + 1][1]), pkbf(sp[2 * I + 1][2], sp[2 * I + 1][3])};
                o = MFMA16(__builtin_bit_cast(bf16x8, ap), __builtin_bit_cast(bf16x8, ((v4u){q0[I].x, q0[I].y, q1[I].x, q1[I].y})), o);
            }
#pragma unroll
            for (int i = 0; i < 8; ++i) {
                sp[i] = MFMA16(((bf16x8){kfr4[i][0], kfr4[i][1], kfr4[i][2], kfr4[i][3], 0, 0, 0, 0}), vfr, sp[i]);
                sp[i] = sp[i] * dvv[i];
            }
            og[bk] = o;
            float ss = (o[0] * o[0] + o[1] * o[1]) + (o[2] * o[2] + o[3] * o[3]);
            ss += __shfl_xor(ss, 16); ss += __shfl_xor(ss, 32); psum[bk] = ss;
        }
        if (g4 == 0) {
#pragma unroll
            for (int bk = 0; bk < 4; ++bk) part[(16 * bk + c15) * 8 + w] = psum[bk];
        }
        LDS_BARRIER();
#pragma unroll
        for (int bk = 0; bk < 4; ++bk) {
            const int t = 16 * bk + c15; const f32x4 pa = *(const LAS f32x4*)(part + t * 8), pb2 = *(const LAS f32x4*)(part + t * 8 + 4);
            const float tot = ((pa[0] + pa[1]) + (pa[2] + pa[3])) + ((pb2[0] + pb2[1]) + (pb2[2] + pb2[3]));
            const float rstd = 1.f / sqrtf(tot * (1.f / 128.f) + RMS_EPS);
            bf16* gp = HG + (row0 + t) * 1024 + hd * 128 + 16 * w + 4 * g4; const v2u g = gcur[bk];
            v2u o; o.x = pkbf(og[bk][0] * rstd * ngv[0] * bflo(g.x), og[bk][1] * rstd * ngv[1] * bfhi(g.x)); o.y = pkbf(og[bk][2] * rstd * ngv[2] * bflo(g.y), og[bk][3] * rstd * ngv[3] * bfhi(g.y));
            *(v2u*)(gp + odelta) = o;
        }
        if (n + 1 < 32) HG_STORE();
        LDS_BARRIER();
    }
#undef HG_LOAD
#undef HG_STORE
}

__device__ __forceinline__ void hgrn_blk_seq(unsigned char* ws, const float* ng, int item, LAS float* sm, int tid) {
    const int b = item >> 3, h = item & 7, dv = tid & 127, kq = tid >> 7, wave = tid >> 6, lane = tid & 63;
    const bf16* HQ = (const bf16*)(ws + WS_HQ); const bf16* HF = (const bf16*)(ws + WS_HF); const bf16* HI = (const bf16*)(ws + WS_HI); bf16* HG = (bf16*)(ws + WS_OABC) + (size_t)M * D;
    const float* DD = (const float*)(ws + WS_HD);
    LAS float* ks = sm; LAS float* qs = sm + 2048; LAS float* part = sm + 4096; LAS float* am = sm + 4096 + 8192; LAS float* ds = am + 256; LAS float* vs = ds + 128;
    float S[32];
#pragma unroll
    for (int i = 0; i < 32; ++i) S[i] = 0.f;
    for (int c0 = 0; c0 < SEQ; c0 += 16) {
        const size_t row0 = (size_t)b * SEQ + c0;
        for (int i = tid; i < 2048; i += 512) { const int t = i >> 7, d = i & 127; ks[i] = bf2f(HF[(row0 + t) * 1024 + h * 128 + d]); qs[i] = bf2f(HQ[(row0 + t) * 1024 + h * 128 + d]); vs[i] = bf2f(HI[(row0 + t) * 1024 + h * 128 + d]); }
        if (tid < 128) ds[tid] = DD[(row0 >> 4) * 1024 + h * 128 + tid];
        __syncthreads();
        if (tid < 256) { const int t = tid >> 4, s = tid & 15; float a = 0.f; if (s <= t) { for (int d = 0; d < 128; ++d) a += qs[t * 128 + d] * ks[s * 128 + d]; } am[tid] = a; }
        __syncthreads();
        for (int t = 0; t < 16; ++t) {
            float po = 0.f;
#pragma unroll
            for (int i = 0; i < 32; ++i) po += qs[t * 128 + kq * 32 + i] * S[i];
            if (kq == 0) { for (int s = 0; s <= t; ++s) po += am[t * 16 + s] * vs[s * 128 + dv]; }
            part[(t * 4 + kq) * 128 + dv] = po;
        }
#pragma unroll
        for (int i = 0; i < 32; ++i) { float u = S[i]; for (int s = 0; s < 16; ++s) u += ks[s * 128 + kq * 32 + i] * vs[s * 128 + dv]; S[i] = u * ds[kq * 32 + i]; }
        __syncthreads();
#pragma unroll
        for (int tt = 0; tt < 2; ++tt) {
            const int t = 2 * wave + tt; float o[2]; float ss = 0.f;
#pragma unroll
            for (int j = 0; j < 2; ++j) { const int c = lane * 2 + j; o[j] = (part[(t * 4) * 128 + c] + part[(t * 4 + 1) * 128 + c]) + (part[(t * 4 + 2) * 128 + c] + part[(t * 4 + 3) * 128 + c]); ss += o[j] * o[j]; }
            const float rstd = 1.f / sqrtf(wave_sum(ss) * (1.f / 128.f) + RMS_EPS);
            bf16* gp = HG + (row0 + t) * 1024 + h * 128 + lane * 2; const unsigned g = *(const unsigned*)gp;
            *(unsigned*)gp = pk2(o[0] * rstd * ng[lane * 2] * bflo(g), o[1] * rstd * ng[lane * 2 + 1] * bfhi(g));
        }
        __syncthreads();
    }
}
#ifndef MK_PHMASK
#define MK_PHMASK 0x3ff
#endif
#define PHEN(j) (((MK_PHMASK) >> (j)) & 1)
#ifndef PROBE_PHASE
#define PROBE_PHASE -1
#endif
#define DUP(j) _Pragma("unroll") for (int rep = (PROBE_PHASE == (j)) ? 0 : 1; rep < 2; ++rep)
constexpr int NPHASES = 19;
#define PHASE_IDS() int tid = threadIdx.x; asm volatile("" : "+v"(tid)); const int lane = tid & 63, wave = __builtin_amdgcn_readfirstlane(tid >> 6); const int gw = vcu * NWAVES + wave; (void)lane; (void)gw
__global__ void __launch_bounds__(NWAVES * 64, 2) mk_fwd(Args args) {
    extern __shared__ __attribute__((aligned(16))) unsigned char lds_raw[];
    LAS unsigned char* lds = (LAS unsigned char*)lds_raw;
    volatile LAS unsigned* MISC = (volatile LAS unsigned*)(lds + MISC_OFF);
    const int G = gridDim.x; const int bx = blockIdx.x;
    const int vcu = (G % 8 == 0) ? (bx % 8) * (G / 8) + bx / 8 : bx;
    const int NGW = G * NWAVES;
    unsigned char* ws = args.ws;
    gu32* ctl = (gu32*)(ws + WS_CTL);
    for (int u = threadIdx.x; u < (LDS_BYTES - LDSCTL_OFF) / 4; u += NWAVES * 64) ((LAS unsigned*)(lds + LDSCTL_OFF))[u] = 0u;
    __syncthreads();
    const int lo = args.ph_lo, hi = args.ph_hi;
    XcdBarrier bar; bar.bar = (unsigned*)(ctl + CW_BAR); bar.x = 0; bar.st = nullptr;
    if (hi - lo > 1) bar = xcd_barrier_post((unsigned*)(ctl + CW_BAR), MISC + 8);
#define IN(k) (lo <= (k) && (k) < hi)
#define SEAM(k) do { if (IN(k) && IN((k) + 1)) xcd_barrier(bar); } while (0)
    float* Hf = args.out;
    bf16* Hb = (bf16*)(ws + WS_HBF);

    if (PHEN(9) && IN(0)) DUP(9) { PHASE_IDS();
        prologue_convert(gw, NGW, lane);
        for (int m = gw; m < M; m += NGW) {
            f32x4 v[4];
#pragma unroll
            for (int j = 0; j < 4; ++j) v[j] = *(const f32x4*)(INP(0) + (size_t)m * D + 4 * lane + 256 * j);
            ln_core(v, INP(1), INP(2), lane);
            store_row_f32(Hf + (size_t)m * D, v, lane); store_row_bf16(Hb + (size_t)m * D, v, lane);
        }
        const int gt = vcu * NWAVES * 64 + tid, NGT = G * NWAVES * 64;
        for (int i = gt; i < SEQ * 64; i += NGT) {
            const int t = i >> 6, dd = i & 63;
            const float inv = (float)exp(-9.210340371976184 * ((double)dd / 63.0));
            const float ang = (float)t * inv;
            ((f32x2*)(ws + WS_ROPE))[i] = (f32x2){(float)cos((double)ang), (float)sin((double)ang)};
        }
        for (int i = gt; i < D; i += NGT) {
            const float p0 = INP(5)[i], p1 = INP(5)[D + i];
            ((float*)(ws + WS_LB))[i] = 1.f / (1.f + expf(p0 - p1));
        }
        for (int i = gt; i < MOE_ROWS; i += NGT) ((int*)(ws + WS_RSLOT))[i] = -1;
    }
    SEAM(0);

    for (int l = 0; l < 2; ++l) {
        const int pb = 1 + 9 * l;
        const bf16* Win = (const bf16*)(ws + WS_WIN) + (size_t)l * NIN * D;
        const bf16* Wout = (const bf16*)(ws + WS_WOUT + (size_t)l * 8 * MiB);
        if (PHEN(0) && IN(pb + 0)) DUP(0) { PHASE_IDS();
            pg8::Gemm g{Hb, Win, M, NIN, D}; pg8::StaticOrder S; S.init(M, NIN, G, bx);
            EpiProj E{ws, (const f32x4*)(ws + WS_ROPE), l ? (const float*)(ws + WS_LB) : nullptr};
            pg8::gemm_phase<EpiProj, pg8::StaticOrder, PG8_ALIGN, PG8_SP2>(lds + RING_OFF, g, S, E);
        }
        SEAM(pb + 0);
        if (PHEN(1) && IN(pb + 1)) { PHASE_IDS();
#if MIX_PROBE_DUP
            for (int rep = 0; rep < 2; ++rep) {
            const long od0 = rep ? 0 : (long)((WS_MERGED - WS_OABC) / 2), od1 = rep ? 0 : od0 - (long)M * D, od2 = rep ? 0 : od0 - 2 * (long)M * D;
#else
            { const int rep = 1; const long od0 = 0, od1 = 0, od2 = 0;
#endif
            for (int vb = bx; vb < 256; vb += G) {
                if (vb < 32) { if (rep || (MIX_PROBE_DUP & 1)) ret_unit(ws, vb, lds + RING_OFF, od0); }
                else if (vb < 96) { if (rep || (MIX_PROBE_DUP & 2)) hgrn_unit(ws, INP(6) + l * 128, vb - 32, lds + RING_OFF, od1); }
                else { if (rep || (MIX_PROBE_DUP & 4)) for (int it = vb - 96; it < 1024; it += 160) swa_unit(ws, INP(8) + l * 16, it, lds + RING_OFF, od2); }
            }
            }
        }
        SEAM(pb + 1);
        if (PHEN(2) && IN(pb + 2)) DUP(2) { PHASE_IDS();
            pg8::Gemm g{(const bf16*)(ws + WS_OABC), Wout, 3 * M, 3 * D, D}; MergeOrder S; S.S.init(M, D, G, bx);
            EpiMerge E{(const bf16*)(ws + WS_GATES), (float*)(ws + WS_MACC), (bf16*)(ws + WS_MERGED)};
            pg8::gemm_phase<EpiMerge, MergeOrder, PG8_ALIGN, PG8_SP2>(lds + RING_OFF, g, S, E);
        }
        SEAM(pb + 2);
        if (PHEN(3) && IN(pb + 3)) DUP(3) { PHASE_IDS(); const bool dummy = (rep == 0);
            pg8::Gemm g{(const bf16*)(ws + WS_MERGED), Wout + (size_t)3 * D * D, M, D, D}; pg8::StaticOrder S; S.init(M, D, G, bx);
            EpiResid E{Hf, dummy ? (float*)(ws + WS_MACC) : Hf};
            pg8::gemm_phase<EpiResid, pg8::StaticOrder, PG8_ALIGN, PG8_SP2>(lds + RING_OFF, g, S, E);
            if (l == 1 && !dummy) DUP(10) { moe_convert(gw, NGW, lane); }
        }
        SEAM(pb + 3);
        if (PHEN(4) && IN(pb + 4)) DUP(4) { PHASE_IDS(); const bool dummy = (rep == 0); float* Hfo = dummy ? (float*)(ws + WS_HIDE) : Hf; bf16* Hbo = dummy ? (bf16*)(ws + WS_HIDE + 64 * MiB) : Hb;
            const float* g_ = INP(11) + l * D; const float* b_ = INP(12) + l * D;
            for (int m = gw; m < M; m += NGW) {
                f32x4 v[4];
#pragma unroll
                for (int j = 0; j < 4; ++j) v[j] = *(const f32x4*)(Hf + (size_t)m * D + 4 * lane + 256 * j);
                ln_core(v, g_, b_, lane);
                store_row_f32(Hfo + (size_t)m * D, v, lane); store_row_bf16(Hbo + (size_t)m * D, v, lane);
                if (l == 1 && !dummy) {
                    float lg[NEXP];
#pragma unroll
                    for (int e = 0; e < NEXP; ++e) lg[e] = 0.f;
                    const float* wr_ = INP(16);
#pragma unroll
                    for (int j = 0; j < 4; ++j)
#pragma unroll
                        for (int q = 0; q < 4; ++q) { const float* wp = wr_ + (size_t)(4 * lane + 256 * j + q) * NEXP; const f32x4 w0 = *(const f32x4*)wp, w1 = *(const f32x4*)(wp + 4); const float x = v[j][q];
                            lg[0] += x * w0[0]; lg[1] += x * w0[1]; lg[2] += x * w0[2]; lg[3] += x * w0[3]; lg[4] += x * w1[0]; lg[5] += x * w1[1]; lg[6] += x * w1[2]; lg[7] += x * w1[3]; }
#pragma unroll
                    for (int e = 0; e < NEXP; ++e) lg[e] = wave_sum(lg[e]);
                    int e0 = 0; float l0 = lg[0];
#pragma unroll
                    for (int e = 1; e < NEXP; ++e) if (lg[e] > l0) { l0 = lg[e]; e0 = e; }
                    int e1 = -1; float l1 = -3.0e38f;
#pragma unroll
                    for (int e = 0; e < NEXP; ++e) if (e != e0 && lg[e] > l1) { l1 = lg[e]; e1 = e; }
                    if (lane == 0) {
                        const float p1 = __expf(l1 - l0), w0 = 1.f / (1.f + p1), w1 = p1 * w0;
                        const int pos0 = (int)__hip_atomic_fetch_add(ctl + CW_ECNT + 64 * e0, 1u, RLX_AGENT), pos1 = (int)__hip_atomic_fetch_add(ctl + CW_ECNT + 64 * e1, 1u, RLX_AGENT);
                        ((int*)(ws + WS_TOKI))[4 * m + 0] = e0; ((int*)(ws + WS_TOKI))[4 * m + 1] = pos0; ((int*)(ws + WS_TOKI))[4 * m + 2] = e1; ((int*)(ws + WS_TOKI))[4 * m + 3] = pos1;
                        ((float*)(ws + WS_TOKW))[2 * m] = w0; ((float*)(ws + WS_TOKW))[2 * m + 1] = w1;
                    }
                }
            }
        }
        SEAM(pb + 4);
        if (l == 0) {
            if (PHEN(6) && IN(pb + 6)) DUP(6) { PHASE_IDS();
                pg8::Gemm g{Hb, (const bf16*)(ws + WS_WGU), M, 2 * DFF, D}; pg8::StaticOrder S; S.init(M, 2 * DFF, G, bx);
                EpiSwiglu E{(bf16*)(ws + WS_HID), DFF, 2 * DFF / 256};
                pg8::gemm_phase<EpiSwiglu, pg8::StaticOrder, PG8_ALIGN, PG8_SP2>(lds + RING_OFF, g, S, E);
            }
            SEAM(pb + 6);
            if (PHEN(7) && IN(pb + 7)) DUP(7) { PHASE_IDS(); const bool dummy = (rep == 0);
                pg8::Gemm g{(const bf16*)(ws + WS_HID), (const bf16*)(ws + WS_WDN), M, D, DFF}; pg8::StaticOrder S; S.init(M, D, G, bx);
                EpiResid E{Hf, dummy ? (float*)(ws + WS_MACC) : Hf};
                pg8::gemm_phase<EpiResid, pg8::StaticOrder, PG8_ALIGN, PG8_SP2>(lds + RING_OFF, g, S, E);
            }
            SEAM(pb + 7);
            if (PHEN(8) && IN(pb + 8)) DUP(8) { PHASE_IDS(); const bool dummy = (rep == 0); float* Hfo = dummy ? (float*)(ws + WS_HIDE) : Hf; bf16* Hbo = dummy ? (bf16*)(ws + WS_HIDE + 64 * MiB) : Hb; (void)Hbo;
                const float* g_ = INP(20); const float* b_ = INP(21);
                for (int m = gw; m < M; m += NGW) {
                    f32x4 v[4];
#pragma unroll
                    for (int j = 0; j < 4; ++j) v[j] = *(const f32x4*)(Hf + (size_t)m * D + 4 * lane + 256 * j);
                    ln_core(v, g_, b_, lane);
                    store_row_f32(Hfo + (size_t)m * D, v, lane); store_row_bf16(Hbo + (size_t)m * D, v, lane);
                }
            }
            SEAM(pb + 8);
        } else {
            const unsigned* ecnt = (const unsigned*)(ctl + CW_ECNT);
            if (PHEN(5) && IN(pb + 5)) DUP(5) { PHASE_IDS();
                int offs[NEXP]; { int p = 0;
#pragma unroll
                    for (int e = 0; e < NEXP; ++e) { offs[e] = p * 256; p += ((int)ecnt[64 * e] + 255) >> 8; } }
                for (int m = gw; m < M; m += NGW) {
                    const int e0 = ((const int*)(ws + WS_TOKI))[4 * m + 0], p0 = ((const int*)(ws + WS_TOKI))[4 * m + 1], e1 = ((const int*)(ws + WS_TOKI))[4 * m + 2], p1 = ((const int*)(ws + WS_TOKI))[4 * m + 3];
                    int r0 = 0, r1 = 0;
#pragma unroll
                    for (int e = 0; e < NEXP; ++e) { if (e == e0) r0 = offs[e] + p0; if (e == e1) r1 = offs[e] + p1; }
                    const v4u a = *(const v4u*)(Hb + (size_t)m * D + 8 * lane), c = *(const v4u*)(Hb + (size_t)m * D + 512 + 8 * lane);
                    bf16* x0 = (bf16*)(ws + WS_XS) + (size_t)r0 * D; bf16* x1 = (bf16*)(ws + WS_XS) + (size_t)r1 * D;
                    *(v4u*)(x0 + 8 * lane) = a; *(v4u*)(x0 + 512 + 8 * lane) = c; *(v4u*)(x1 + 8 * lane) = a; *(v4u*)(x1 + 512 + 8 * lane) = c;
                    if (lane == 0) { ((int*)(ws + WS_RSLOT))[r0] = 2 * m; ((int*)(ws + WS_RSLOT))[r1] = 2 * m + 1;
                        ((float*)(ws + WS_RW))[r0] = ((const float*)(ws + WS_TOKW))[2 * m]; ((float*)(ws + WS_RW))[r1] = ((const float*)(ws + WS_TOKW))[2 * m + 1]; }
                }
            }
            SEAM(pb + 5);
            if (PHEN(6) && IN(pb + 6)) DUP(6) { PHASE_IDS();
                pg8::Gemm g{(const bf16*)(ws + WS_XS), (const bf16*)(ws + WS_WGUE), MOE_ROWS, NEXP * 2 * DEXP, D}; MoeOrder S; S.init(ecnt, 2 * DEXP / 256, G, bx);
                EpiSwiglu E{(bf16*)(ws + WS_HIDE), DEXP, 2 * DEXP / 256};
                pg8::gemm_phase<EpiSwiglu, MoeOrder, PG8_ALIGN, PG8_SP2>(lds + RING_OFF, g, S, E);
            }
            SEAM(pb + 6);
            if (PHEN(7) && IN(pb + 7)) DUP(7) { PHASE_IDS(); const bool dummy = (rep == 0);
                pg8::Gemm g{(const bf16*)(ws + WS_HIDE), (const bf16*)(ws + WS_WDNE), MOE_ROWS, NEXP * D, DEXP}; MoeOrder S; S.init(ecnt, D / 256, G, bx);
                EpiMoeDown E{(bf16*)(ws + WS_YS), (const int*)(ws + WS_RSLOT), (const float*)(ws + WS_RW)};
                pg8::gemm_phase<EpiMoeDown, MoeOrder, PG8_ALIGN, PG8_SP2>(lds + RING_OFF, g, S, E);
            }
            SEAM(pb + 7);
            if (PHEN(8) && IN(pb + 8)) DUP(8) { PHASE_IDS(); const bool dummy = (rep == 0); float* Hfo = dummy ? (float*)(ws + WS_HIDE) : Hf; bf16* Hbo = dummy ? (bf16*)(ws + WS_HIDE + 64 * MiB) : Hb; (void)Hbo;
                const float* g_ = INP(20) + D; const float* b_ = INP(21) + D; const bf16* YS = (const bf16*)(ws + WS_YS);
                for (int m = gw; m < M; m += NGW) {
                    f32x4 v[4];
#pragma unroll
                    for (int j = 0; j < 4; ++j) {
                        const f32x4 h = *(const f32x4*)(Hf + (size_t)m * D + 4 * lane + 256 * j);
                        const v2u y0 = *(const v2u*)(YS + (size_t)(2 * m) * D + 4 * lane + 256 * j), y1 = *(const v2u*)(YS + (size_t)(2 * m + 1) * D + 4 * lane + 256 * j);
                        const f32x4 a = (f32x4){bflo(y0.x), bfhi(y0.x), bflo(y0.y), bfhi(y0.y)}, c = (f32x4){bflo(y1.x), bfhi(y1.x), bflo(y1.y), bfhi(y1.y)};
                        v[j] = h * DN_ALPHA + (a + c);
                    }
                    ln_core(v, g_, b_, lane);
                    store_row_f32(Hfo + (size_t)m * D, v, lane);
                }
            }
        }
    }
#undef IN
#undef SEAM
}

extern "C" void kernel_launch(void* const* d_in, const int* in_sizes, int n_in, void* d_out, int out_size, void* d_ws, size_t ws_size, hipStream_t stream) {
    static int grid = 0;
    if (grid == 0) {
        if (n_in != 22 || out_size != M * D || ws_size < WS_END) { fprintf(stderr, "kernel_launch: unexpected problem shape (n_in %d, out %d, ws %zu); nothing launched\n", n_in, out_size, ws_size); grid = -1; return; }
        int dev = 0, cus = 0, per_cu = 0;
        if (hipGetDevice(&dev) != hipSuccess || hipDeviceGetAttribute(&cus, hipDeviceAttributeMultiprocessorCount, dev) != hipSuccess) { grid = -1; return; }
        if (hipFuncSetAttribute((const void*)mk_fwd, hipFuncAttributeMaxDynamicSharedMemorySize, LDS_BYTES) != hipSuccess) { fprintf(stderr, "kernel_launch: hipFuncSetAttribute failed\n"); grid = -1; return; }
        if (hipOccupancyMaxActiveBlocksPerMultiprocessor(&per_cu, (const void*)mk_fwd, NWAVES * 64, LDS_BYTES) != hipSuccess || per_cu < 1) { fprintf(stderr, "kernel_launch: occupancy query says %d\n", per_cu); }
        (void)hipGetLastError();
        grid = cus;
    }
    if (grid < 0) return;
    if (hipMemsetAsync((char*)d_ws + WS_CTL, 0, CTL_ZERO_BYTES, stream) != hipSuccess) return;
    Args a{};
    for (int i = 0; i < 22; ++i) a.in[i] = (const float*)d_in[i];
    a.out = (float*)d_out; a.ws = (unsigned char*)d_ws;
#if MK_SINGLE
    a.ph_lo = 0; a.ph_hi = NPHASES;
    hipLaunchKernelGGL(mk_fwd, dim3(grid), dim3(NWAVES * 64), LDS_BYTES, stream, a);
#else
    for (int p = 0; p < NPHASES; ++p) {
        if (p == 6) continue;
        a.ph_lo = p; a.ph_hi = p + 1;
        hipLaunchKernelGGL(mk_fwd, dim3(grid), dim3(NWAVES * 64), LDS_BYTES, stream, a);
    }
#endif
}
```
